# Optimizing an MI355X kernel written in HIP

```python
import math
import jax, jax.numpy as jnp
from jax import lax
import numpy as np

D_MODEL = 2048
BATCH = 4
SEQ = 4096
DEPTH = 2

D_FF = 5632
SSM_HEADS = 16
SSM_HEAD_DIM = 64
SSM_D_INNER = SSM_HEADS * SSM_HEAD_DIM
SSM_GROUPS = 2
SSM_STATE = 128
SSM_CONV = 4
SSM_CONV_DIM = SSM_D_INNER + 2 * SSM_GROUPS * SSM_STATE
SSD_CHUNK = 256
MLA_HEADS = 8
MLA_Q_LORA = 768
MLA_KV_LORA = 512
MLA_NOPE = 128
MLA_ROPE = 64
MLA_QK_DIM = MLA_NOPE + MLA_ROPE
MLA_V = 128
MLA_WIDTH = MLA_HEADS * MLA_V
ATTN_Q_BLOCK = 128
RET_HEADS = 4
RET_QK_HEAD = 256
RET_V_HEAD = 256
RET_QK = RET_HEADS * RET_QK_HEAD
RET_V = RET_HEADS * RET_V_HEAD
RET_CHUNK = 256
N_BRANCH = 3
ROPE_THETA = 10000.0
NORM_EPS = 1e-6
IN_SPLITS = (SSM_D_INNER, SSM_CONV_DIM, SSM_HEADS,
             MLA_Q_LORA, MLA_KV_LORA + MLA_ROPE,
             RET_QK, RET_QK, RET_V, RET_V,
             N_BRANCH * D_MODEL)
D_IN = sum(IN_SPLITS)

kernel_name = 'hybrid_ssd_mla_retention_macaron'


def rmsnorm(x, w):
    xf = x.astype(jnp.float32)
    y = xf * lax.rsqrt(jnp.mean(xf * xf, axis=-1, keepdims=True) + NORM_EPS)
    return (y * w.astype(jnp.float32)).astype(x.dtype)


def swiglu(x, w_gate, w_up, w_down):
    return (jax.nn.silu(x @ w_gate) * (x @ w_up)) @ w_down


def rope_tables(positions, dim):
    inv = 1.0 / (ROPE_THETA ** (jnp.arange(0, dim, 2, dtype=jnp.float32) / dim))
    ang = positions.astype(jnp.float32)[..., None] * inv
    return jnp.cos(ang), jnp.sin(ang)


def apply_rope(x, cos, sin):
    x1, x2 = jnp.split(x, 2, axis=-1)
    c = cos[:, :, None, :]
    s = sin[:, :, None, :]
    return jnp.concatenate([x1 * c - x2 * s, x1 * s + x2 * c], axis=-1).astype(x.dtype)


def causal_depthwise_conv(x, w, b):
    k = w.shape[0]
    out = lax.conv_general_dilated(
        x, w[:, None, :].astype(x.dtype), window_strides=(1,), padding=[(k - 1, 0)],
        dimension_numbers=('NWC', 'WIO', 'NWC'), feature_group_count=x.shape[-1])
    return out + b


def ssd_chunked(xs, dt, a, bm, cm):
    b, s, h, p = xs.shape
    g, n = bm.shape[2], bm.shape[3]
    r = h // g
    L = math.gcd(s, SSD_CHUNK)
    nc = s // L
    xd = (xs * dt[..., None]).reshape(b, nc, L, g, r, p)
    adt = (dt * a).reshape(b, nc, L, g, r)
    bm = bm.reshape(b, nc, L, g, n)
    cm = cm.reshape(b, nc, L, g, n)
    acs = jnp.cumsum(adt, axis=2)
    causal = jnp.tril(jnp.ones((L, L), dtype=bool))[None, None, :, :, None, None]
    seg = acs[:, :, :, None] - acs[:, :, None, :]
    decay = jnp.exp(jnp.where(causal, seg, -jnp.inf))
    cb = jnp.einsum('bctgn,bcsgn->bctsg', cm, bm)
    y_diag = jnp.einsum('bctsgr,bcsgrp->bctgrp', cb[..., None] * decay, xd)
    xdd = xd * jnp.exp(acs[:, :, -1:] - acs)[..., None]
    states = jnp.einsum('bcsgn,bcsgrp->bcgrpn', bm, xdd)
    chunk_decay = jnp.exp(acs[:, :, -1])

    def carry_state(state, inp):
        st, dec = inp
        return state * dec[..., None, None] + st, state

    init = jnp.zeros((b, g, r, p, n), states.dtype)
    _, prev = lax.scan(carry_state, init,
                       (jnp.swapaxes(states, 0, 1), jnp.swapaxes(chunk_decay, 0, 1)))
    prev = jnp.swapaxes(prev, 0, 1)
    y_off = jnp.einsum('bctgn,bcgrpn->bctgrp', cm, prev) * jnp.exp(acs)[..., None]
    return (y_diag + y_off).reshape(b, s, h, p)


def retention_chunked(q, k, v):
    b, s, h, dk = q.shape
    dv = v.shape[-1]
    L = math.gcd(s, RET_CHUNK)
    nc = s // L
    expo = 5.0 + 7.0 * jnp.arange(h, dtype=jnp.float32) / (h - 1)
    log_gamma = jnp.log1p(-jnp.exp2(-expo))
    pos = jnp.arange(L, dtype=jnp.float32)
    rel = pos[:, None] - pos[None, :]
    dmask = jnp.where(rel[None] >= 0, jnp.exp(rel[None] * log_gamma[:, None, None]), 0.0).astype(q.dtype)
    q = q.reshape(b, nc, L, h, dk)
    k = k.reshape(b, nc, L, h, dk)
    v = v.reshape(b, nc, L, h, dv)
    scores = jnp.einsum('bcthd,bcshd->bchts', q, k) * dmask
    y_in = jnp.einsum('bchts,bcshe->bcthe', scores, v)
    k_dec = jnp.exp((L - 1 - pos)[:, None] * log_gamma).astype(q.dtype)
    states = jnp.einsum('bcshd,bcshe->bchde', k * k_dec[None, None, :, :, None], v)
    chunk_decay = jnp.exp(L * log_gamma).astype(q.dtype)

    def carry_state(state, st):
        return state * chunk_decay[None, :, None, None] + st, state

    init = jnp.zeros((b, h, dk, dv), states.dtype)
    _, prev = lax.scan(carry_state, init, jnp.swapaxes(states, 0, 1))
    prev = jnp.swapaxes(prev, 0, 1)
    q_dec = jnp.exp((pos + 1)[:, None] * log_gamma).astype(q.dtype)
    y_cross = jnp.einsum('bcthd,bchde->bcthe', q, prev) * q_dec[None, None, :, :, None]
    return (y_in + y_cross).reshape(b, s, h, dv)


def causal_attention_blocks(q, k, v, scale):
    b, s, h, d = q.shape
    nb = s // ATTN_Q_BLOCK
    qb = jnp.swapaxes(q.reshape(b, nb, ATTN_Q_BLOCK, h, d), 0, 1)
    kpos = jnp.arange(s)

    def one_block(args):
        qi, i = args
        sc = jnp.einsum('bqhd,bkhd->bhqk', qi, k).astype(jnp.float32) * scale
        qpos = i * ATTN_Q_BLOCK + jnp.arange(ATTN_Q_BLOCK)
        sc = jnp.where(kpos[None, :] <= qpos[:, None], sc, -jnp.inf)
        pr = jax.nn.softmax(sc, axis=-1).astype(v.dtype)
        return jnp.einsum('bhqk,bkhe->bqhe', pr, v)

    out = lax.map(one_block, (qb, jnp.arange(nb)))
    return jnp.swapaxes(out, 0, 1).reshape(b, s, h, v.shape[-1])


def ssm_branch(z, xbc, dt_raw, conv_w, conv_b, dt_bias, a_log, d_skip, ssm_norm):
    b, s, _ = z.shape
    xbc = jax.nn.silu(causal_depthwise_conv(xbc, conv_w, conv_b))
    xs, bm, cm = jnp.split(xbc, [SSM_D_INNER, SSM_D_INNER + SSM_GROUPS * SSM_STATE], axis=-1)
    xs = xs.reshape(b, s, SSM_HEADS, SSM_HEAD_DIM)
    bm = bm.reshape(b, s, SSM_GROUPS, SSM_STATE)
    cm = cm.reshape(b, s, SSM_GROUPS, SSM_STATE)
    dt = jax.nn.softplus(dt_raw.astype(jnp.float32) + dt_bias.astype(jnp.float32))
    a = -jnp.exp(a_log.astype(jnp.float32))
    y = ssd_chunked(xs, dt, a, bm, cm) + d_skip[:, None] * xs
    y = y.reshape(b, s, SSM_D_INNER) * jax.nn.silu(z)
    y = rmsnorm(y.reshape(b, s, SSM_GROUPS, SSM_D_INNER // SSM_GROUPS),
                ssm_norm.reshape(SSM_GROUPS, SSM_D_INNER // SSM_GROUPS))
    return y.reshape(b, s, SSM_D_INNER).astype(z.dtype)


def mla_branch(q_lat, kv_lat, cos, sin, q_a_norm, w_q_b, kv_a_norm, w_kv_b, q_norm, k_norm):
    b, s, _ = q_lat.shape
    q = (rmsnorm(q_lat, q_a_norm) @ w_q_b).reshape(b, s, MLA_HEADS, MLA_QK_DIM)
    c_kv, k_pe = jnp.split(kv_lat, [MLA_KV_LORA], axis=-1)
    kv = (rmsnorm(c_kv, kv_a_norm) @ w_kv_b).reshape(b, s, MLA_HEADS, MLA_NOPE + MLA_V)
    k_nope, v = jnp.split(kv, [MLA_NOPE], axis=-1)
    k = jnp.concatenate([k_nope, jnp.broadcast_to(k_pe[:, :, None, :], (b, s, MLA_HEADS, MLA_ROPE))], axis=-1)
    q = rmsnorm(q, q_norm)
    k = rmsnorm(k, k_norm)
    q = jnp.concatenate([q[..., :MLA_NOPE], apply_rope(q[..., MLA_NOPE:], cos, sin)], axis=-1)
    k = jnp.concatenate([k[..., :MLA_NOPE], apply_rope(k[..., MLA_NOPE:], cos, sin)], axis=-1)
    o = causal_attention_blocks(q, k, v, MLA_QK_DIM ** -0.5)
    return o.reshape(b, s, MLA_WIDTH)


def retention_branch(rq, rk, rv, rg, cos, sin, ret_norm):
    b, s, _ = rq.shape
    q = apply_rope(rq.reshape(b, s, RET_HEADS, RET_QK_HEAD), cos, sin)
    k = apply_rope(rk.reshape(b, s, RET_HEADS, RET_QK_HEAD), cos, sin) * (RET_QK_HEAD ** -0.5)
    v = rv.reshape(b, s, RET_HEADS, RET_V_HEAD)
    y = retention_chunked(q, k, v)
    y = rmsnorm(y, ret_norm.reshape(RET_HEADS, RET_V_HEAD)).reshape(b, s, RET_V)
    return jax.nn.silu(rg) * y


def hybrid_mixer(h, cos_mla, sin_mla, cos_ret, sin_ret, w_in, gate_b, conv_w, conv_b,
                 dt_bias, a_log, d_skip, ssm_norm, q_a_norm, w_q_b, kv_a_norm, w_kv_b,
                 q_norm, k_norm, ret_norm, w_br_ssm, w_br_mla, w_br_ret, w_out):
    b, s, d = h.shape
    proj = h @ w_in
    idx = np.cumsum(IN_SPLITS)[:-1].tolist()
    z, xbc, dt_raw, q_lat, kv_lat, rq, rk, rv, rg, gates = jnp.split(proj, idx, axis=-1)
    y_ssm = ssm_branch(z, xbc, dt_raw, conv_w, conv_b, dt_bias, a_log, d_skip, ssm_norm)
    y_mla = mla_branch(q_lat, kv_lat, cos_mla, sin_mla, q_a_norm, w_q_b, kv_a_norm, w_kv_b, q_norm, k_norm)
    y_ret = retention_branch(rq, rk, rv, rg, cos_ret, sin_ret, ret_norm)
    g = jax.nn.sigmoid((gates + gate_b).astype(jnp.float32)).astype(h.dtype).reshape(b, s, N_BRANCH, d)
    merged = (g[:, :, 0] * (y_ssm @ w_br_ssm)
              + g[:, :, 1] * (y_mla @ w_br_mla)
              + g[:, :, 2] * (y_ret @ w_br_ret))
    return merged @ w_out


def setup_inputs(seed: int = 0) -> dict:
    key = jax.random.key(seed)
    ks = iter(jax.random.split(key, 48))

    def normal(shape, scale):
        return scale * jax.random.normal(next(ks), shape, jnp.float32)

    def gain(shape):
        return 1.0 + normal(shape, 0.05)

    L_ = DEPTH
    x = normal((BATCH, SEQ, D_MODEL), 1.0)
    offset = jax.random.randint(next(ks), (BATCH, 1), 0, 1024, dtype=jnp.int32)
    positions = (offset + jnp.arange(SEQ, dtype=jnp.int32)[None, :]).astype(jnp.int32)
    dt0 = jnp.exp(jax.random.uniform(next(ks), (L_, SSM_HEADS), jnp.float32,
                                     math.log(1e-3), math.log(1e-1)))
    dt_bias = dt0 + jnp.log(-jnp.expm1(-dt0))
    a_log = jnp.log(jax.random.uniform(next(ks), (L_, SSM_HEADS), jnp.float32, 1.0, 16.0))
    return {
        'x': x,
        'positions': positions,
        'ffn1_norm': gain((L_, D_MODEL)),
        'ffn1_w_gate': normal((L_, D_MODEL, D_FF), D_MODEL ** -0.5),
        'ffn1_w_up': normal((L_, D_MODEL, D_FF), D_MODEL ** -0.5),
        'ffn1_w_down': normal((L_, D_FF, D_MODEL), D_FF ** -0.5),
        'mix_norm': gain((L_, D_MODEL)),
        'w_in': normal((L_, D_MODEL, D_IN), D_MODEL ** -0.5),
        'gate_b': normal((L_, N_BRANCH * D_MODEL), 0.01),
        'conv_w': normal((L_, SSM_CONV, SSM_CONV_DIM), SSM_CONV ** -0.5),
        'conv_b': normal((L_, SSM_CONV_DIM), 0.01),
        'dt_bias': dt_bias,
        'a_log': a_log,
        'd_skip': gain((L_, SSM_HEADS)),
        'ssm_norm': gain((L_, SSM_D_INNER)),
        'q_a_norm': gain((L_, MLA_Q_LORA)),
        'w_q_b': normal((L_, MLA_Q_LORA, MLA_HEADS * MLA_QK_DIM), MLA_Q_LORA ** -0.5),
        'kv_a_norm': gain((L_, MLA_KV_LORA)),
        'w_kv_b': normal((L_, MLA_KV_LORA, MLA_HEADS * (MLA_NOPE + MLA_V)), MLA_KV_LORA ** -0.5),
        'q_norm': gain((L_, MLA_QK_DIM)),
        'k_norm': gain((L_, MLA_QK_DIM)),
        'ret_norm': gain((L_, RET_V)),
        'w_br_ssm': normal((L_, SSM_D_INNER, D_MODEL), SSM_D_INNER ** -0.5),
        'w_br_mla': normal((L_, MLA_WIDTH, D_MODEL), MLA_WIDTH ** -0.5),
        'w_br_ret': normal((L_, RET_V, D_MODEL), RET_V ** -0.5),
        'w_out': normal((L_, D_MODEL, D_MODEL), D_MODEL ** -0.5),
        'ffn2_norm': gain((L_, D_MODEL)),
        'ffn2_w_gate': normal((L_, D_MODEL, D_FF), D_MODEL ** -0.5),
        'ffn2_w_up': normal((L_, D_MODEL, D_FF), D_MODEL ** -0.5),
        'ffn2_w_down': normal((L_, D_FF, D_MODEL), D_FF ** -0.5),
    }


def reference(x, positions, ffn1_norm, ffn1_w_gate, ffn1_w_up, ffn1_w_down, mix_norm, w_in,
              gate_b, conv_w, conv_b, dt_bias, a_log, d_skip, ssm_norm, q_a_norm, w_q_b,
              kv_a_norm, w_kv_b, q_norm, k_norm, ret_norm, w_br_ssm, w_br_mla, w_br_ret,
              w_out, ffn2_norm, ffn2_w_gate, ffn2_w_up, ffn2_w_down):
    cos_mla, sin_mla = rope_tables(positions, MLA_ROPE)
    cos_ret, sin_ret = rope_tables(positions, RET_QK_HEAD)
    for l in range(DEPTH):
        x = x + 0.5 * swiglu(rmsnorm(x, ffn1_norm[l]), ffn1_w_gate[l], ffn1_w_up[l], ffn1_w_down[l])
        x = x + hybrid_mixer(rmsnorm(x, mix_norm[l]), cos_mla, sin_mla, cos_ret, sin_ret,
                             w_in[l], gate_b[l], conv_w[l], conv_b[l], dt_bias[l], a_log[l],
                             d_skip[l], ssm_norm[l], q_a_norm[l], w_q_b[l], kv_a_norm[l],
                             w_kv_b[l], q_norm[l], k_norm[l], ret_norm[l], w_br_ssm[l],
                             w_br_mla[l], w_br_ret[l], w_out[l])
        x = x + 0.5 * swiglu(rmsnorm(x, ffn2_norm[l]), ffn2_w_gate[l], ffn2_w_up[l], ffn2_w_down[l])
    return x
```

```cpp
#include <hip/hip_runtime.h>
#include <hip/hip_cooperative_groups.h>
#include <cstdio>
#include <cstdint>
namespace cg = cooperative_groups;

#define LAS __attribute__((address_space(3)))
typedef unsigned short bf16_t;
typedef short bf16x8 __attribute__((ext_vector_type(8)));
typedef float f32x4 __attribute__((ext_vector_type(4)));
typedef float f32x2 __attribute__((ext_vector_type(2)));
typedef float f32x16 __attribute__((ext_vector_type(16)));
typedef unsigned u32x4 __attribute__((ext_vector_type(4)));
typedef unsigned u32x2 __attribute__((ext_vector_type(2)));
typedef __bf16 bf16x2_t __attribute__((ext_vector_type(2)));

constexpr int T = 16384, SEQ = 4096, NBATCH = 4, DM = 2048, DFF = 5632, DIN = 14160, NPROJ = 14336  , LDP = 8192  , DEPTH = 2;
constexpr int Z0 = 0, XBC0 = 1024, QL0 = 2560, KVL0 = 3328, KPE0 = 3840, DT0 = 3904, RQ0 = 4096, RK0 = 5120, RV0 = 6144, RG0 = 7168, GT0 = 8192;
constexpr float LOG2E = 1.4426950408889634f;

constexpr size_t MB = 1000000;
constexpr size_t al(size_t x) { return (x + 4095) / 4096 * 4096; }
constexpr size_t WS_CTL = 0;
constexpr size_t WS_A2S = 65536;
constexpr size_t WS_A2R = WS_A2S + (size_t)4 * 16 * 4096 * 4;
constexpr size_t WS_A2BT = WS_A2R + 4 * 4096 * 4;
constexpr size_t WS_WS = al(WS_A2BT + 4 * 16 * 64 * 4);
constexpr size_t WQB_OFF = 0, WKVB_OFF = (size_t)1536 * 768 * 2, WBR_OFF = WKVB_OFF + (size_t)2048 * 512 * 2, WOUT_OFF = WBR_OFF + (size_t)3 * 2048 * 1024 * 2;
constexpr size_t WS_WA = al(WS_WS + WOUT_OFF + (size_t)2048 * 2048 * 2);
constexpr size_t WA_BYTES = (size_t)T * 2048 * 2;
constexpr size_t WS_H = al(WS_WA + WA_BYTES);
constexpr size_t WS_BIG = al(WS_H + (size_t)T * 2048 * 2);
constexpr size_t BIG_BYTES = (size_t)T * NPROJ * 2;
constexpr size_t GATE_OFF = (size_t)T * LDP * 2;
constexpr size_t FFW_GU = 0, FFW_DN = (size_t)11264 * 2048 * 2, FF_HID = FFW_DN + (size_t)2048 * 5632 * 2;
constexpr size_t WS_R1 = al(WS_BIG + BIG_BYTES);
constexpr size_t R1_BYTES = (size_t)T * (1536 + 2048) * 2;
constexpr size_t WS_R2 = al(WS_R1 + R1_BYTES);
constexpr size_t R2_BYTES = (size_t)T * 2048 * 4;
constexpr size_t WS_Y = al(WS_R2 + R2_BYTES);
constexpr size_t WS_END = WS_Y + (size_t)3 * T * 1024 * 2;
static_assert(FF_HID + (size_t)T * DFF * 2 <= BIG_BYTES, "ffn overlay");
static_assert((size_t)T * 8 * (192 + 192 + 128) * 2 <= R2_BYTES, "R2");

struct Params {
    const float* in[30];
    float* out;
    unsigned char* ws;
};

template <class T> __device__ __forceinline__ T* as_global(T* p) { return (T*)(__attribute__((address_space(1))) T*)p; }
__device__ __forceinline__ float bf2f(unsigned v) { return __uint_as_float(v << 16); }
__device__ __forceinline__ unsigned pk2(float lo, float hi) { f32x2 v = {lo, hi}; bf16x2_t b = __builtin_convertvector(v, bf16x2_t); return __builtin_bit_cast(unsigned, b); }
__device__ __forceinline__ float ex2(float x) { return __builtin_amdgcn_exp2f(x); }
__device__ __forceinline__ float rcpf_(float x) { return __builtin_amdgcn_rcpf(x); }
__device__ __forceinline__ float sigmoidf_(float x) { return rcpf_(1.f + ex2(-x * LOG2E)); }
__device__ __forceinline__ float siluf_(float x) { return x * sigmoidf_(x); }
__device__ __forceinline__ float wave_sum(float v) {
#pragma unroll
    for (int o = 1; o < 64; o <<= 1) v += __shfl_xor(v, o);
    return v;
}
__device__ __forceinline__ void sincos_rev(float ang, float& c, float& s) {
    double rev = (double)ang * 0.15915494309189535; rev -= floor(rev);
    float fr = (float)rev; s = __builtin_amdgcn_sinf(fr); c = __builtin_amdgcn_cosf(fr);
}

namespace pg8 {
constexpr int BM = 256, BK = 64, HALF = 128, HTB = HALF * BK * 2, STAGE_BYTES = 8 * HTB, NXCD = 8, WGM = 8;
__host__ __device__ __forceinline__ int lds_byte(int r, int c) { const int st = (r >> 4) * 2 + (c >> 5), rr = r & 15, cc = c & 31, ob = rr * 64 + cc * 2; return st * 1024 + (ob ^ (((ob >> 9) & 1) << 5)); }
__host__ __device__ __forceinline__ void stage_rc(int b, int& R, int& C) { const int st = b / 1024, sb = b % 1024, swz = sb ^ (((sb >> 9) & 1) << 5); R = (st >> 1) * 16 + swz / 64; C = (st & 1) * 32 + (swz % 64) / 2; }
__host__ __device__ __forceinline__ int perm32(int rho) { const int n = rho >> 4, i = rho & 15; return 8 * (i >> 2) + 4 * n + (i & 3); }

struct Unit { int pm, pn; };
struct Gemm { const bf16_t* A; const bf16_t* Bt; int M, N, K, lda; int blockedA, blockedB; };

struct StaticOrder {
    int nM, nN, nwg, G, c;
    __device__ void init(int M, int N, int G_, int c_) { nM = M / BM; nN = N / BM; nwg = nM * nN; G = G_; c = c_; }
    __device__ bool next(int i, Unit& u) const {
        const long L = (long)i * G + c; if (L >= nwg) return false;
        int wgid = (int)L; { const int q = nwg / NXCD, r = nwg % NXCD, xcd = wgid % NXCD, off = wgid / NXCD; wgid = (xcd < r ? xcd * (q + 1) : r * (q + 1) + (xcd - r) * q) + off; }
        const int nig = WGM * nN, gid = wgid / nig, fm = gid * WGM, gsz = (nM - fm) < WGM ? (nM - fm) : WGM;
        u.pm = fm + ((wgid % nig) % gsz); u.pn = (wgid % nig) / gsz; return true;
    }
};
struct MergeOrder {
    StaticOrder so;
    __device__ bool next(int i, Unit& u) const { Unit b; if (!so.next(i / 3, b)) return false; const int br = i % 3; u.pm = br * 64 + b.pm; u.pn = br * 8 + b.pn; return true; }
};

struct EpiBf16 {
    static constexpr bool PERM = true;
    bf16_t* O; int ldc; const float* gbias; int gate0; bf16_t* G;
    __device__ __forceinline__ void operator()(const f32x4 (&acc)[2][2][4][2], const Unit& u, int wr, int wc, int fr, int fq) const {
        const int row0 = u.pm * BM + wr * 64 + fr, col0 = u.pn * BM + wc * 32 + 8 * fq;
        const bool gate = gbias != nullptr && u.pn * BM >= gate0;
        f32x4 gb[2][2];
        if (gate) {
#pragma unroll
            for (int bj = 0; bj < 2; ++bj)
#pragma unroll
                for (int n = 0; n < 2; ++n) gb[bj][n] = *(const f32x4*)(gbias + (col0 - gate0) + bj * HALF + 4 * n); }
#pragma unroll
        for (int ai = 0; ai < 2; ++ai)
#pragma unroll
            for (int m = 0; m < 4; ++m) {
                bf16_t* rowp = gate ? G + ((size_t)((((u.pn - gate0 / BM) >> 3) * 64 + u.pm) * 8 + ((u.pn - gate0 / BM) & 7)) * 256 + (wr * 64 + fr + ai * HALF + m * 16)) * 256 + wc * 32 + 8 * fq
                                    : O + (size_t)(row0 + ai * HALF + m * 16) * ldc + col0;
#pragma unroll
                for (int bj = 0; bj < 2; ++bj) { f32x4 v0 = acc[ai][bj][m][0], v1 = acc[ai][bj][m][1];
                    if (gate) {
#pragma unroll
                        for (int j = 0; j < 4; ++j) { v0[j] = sigmoidf_(v0[j] + gb[bj][0][j]); v1[j] = sigmoidf_(v1[j] + gb[bj][1][j]); } }
                    u32x4 w; w.x = pk2(v0[0], v0[1]); w.y = pk2(v0[2], v0[3]); w.z = pk2(v1[0], v1[1]); w.w = pk2(v1[2], v1[3]);
                    *(u32x4*)(rowp + bj * HALF) = w; } }
    }
};
struct EpiSwiGLU {
    static constexpr bool PERM = true;
    bf16_t* O; int ldc;
    __device__ __forceinline__ void operator()(const f32x4 (&acc)[2][2][4][2], const Unit& u, int wr, int wc, int fr, int fq) const {
        const int row0 = u.pm * BM + wr * 64 + fr, col0 = u.pn * HALF + wc * 32 + 8 * fq;
#pragma unroll
        for (int ai = 0; ai < 2; ++ai)
#pragma unroll
            for (int m = 0; m < 4; ++m) { const int r = row0 + ai * HALF + m * 16;
                bf16_t* rowp = O + ((size_t)((r >> 8) * (ldc >> 6) + (col0 >> 6)) * 256 + (r & 255)) * 64 + (col0 & 63);
                float h[8];
#pragma unroll
                for (int n = 0; n < 2; ++n)
#pragma unroll
                    for (int j = 0; j < 4; ++j) h[n * 4 + j] = siluf_(acc[ai][0][m][n][j]) * acc[ai][1][m][n][j];
                u32x4 w; w.x = pk2(h[0], h[1]); w.y = pk2(h[2], h[3]); w.z = pk2(h[4], h[5]); w.w = pk2(h[6], h[7]);
                *(u32x4*)rowp = w; }
    }
};
struct EpiResid {
    static constexpr bool PERM = false;
    const float* base; float* out; float scale;
    __device__ __forceinline__ void operator()(const f32x4 (&acc)[2][2][4][2], const Unit& u, int wr, int wc, int fr, int fq) const {
        const int row0 = u.pm * BM + wr * 64 + fr, col0 = u.pn * BM + wc * 32 + 4 * fq;
#pragma unroll
        for (int ai = 0; ai < 2; ++ai) {
            f32x4 bv[4][2][2];
#pragma unroll
            for (int m = 0; m < 4; ++m) { const size_t off = (size_t)(row0 + ai * HALF + m * 16) * DM + col0;
#pragma unroll
                for (int bj = 0; bj < 2; ++bj)
#pragma unroll
                    for (int n = 0; n < 2; ++n) bv[m][bj][n] = *(const f32x4*)(base + off + bj * HALF + n * 16); }
#pragma unroll
            for (int m = 0; m < 4; ++m) { const size_t off = (size_t)(row0 + ai * HALF + m * 16) * DM + col0;
#pragma unroll
                for (int bj = 0; bj < 2; ++bj)
#pragma unroll
                    for (int n = 0; n < 2; ++n) *(f32x4*)(out + off + bj * HALF + n * 16) = bv[m][bj][n] + acc[ai][bj][m][n] * scale; }
            asm volatile("" ::: "memory");
        }
    }
};
struct EpiMerge {
    static constexpr bool PERM = true;
    const bf16_t* proj; bf16_t* Mg;
    __device__ __forceinline__ void operator()(const f32x4 (&acc)[2][2][4][2], const Unit& u, int wr, int wc, int fr, int fq) const {
        const int br = u.pn >> 3, pn = u.pn & 7, pm = u.pm & 63;
        const int row0 = pm * BM + wr * 64 + fr, col0 = pn * BM + wc * 32 + 8 * fq;
#pragma unroll
        for (int ai = 0; ai < 2; ++ai) {
            u32x4 gw[4][2], pw[4][2];
#pragma unroll
            for (int m = 0; m < 4; ++m) { const int row = row0 + ai * HALF + m * 16;
#pragma unroll
                for (int bj = 0; bj < 2; ++bj) { const int col = col0 + bj * HALF;
                    gw[m][bj] = *(const u32x4*)(proj + ((size_t)((br * 64 + pm) * 8 + pn) * 256 + (row & 255)) * 256 + (col & 255));
                    pw[m][bj] = *(const u32x4*)(Mg + ((size_t)((row >> 8) * (DM / 64) + (col >> 6)) * 256 + (row & 255)) * 64 + (col & 63)); } }
#pragma unroll
            for (int m = 0; m < 4; ++m) { const int row = row0 + ai * HALF + m * 16;
#pragma unroll
                for (int bj = 0; bj < 2; ++bj) { const int col = col0 + bj * HALF;
                    const f32x4 v0 = acc[ai][bj][m][0], v1 = acc[ai][bj][m][1]; const u32x4 g = gw[m][bj]; const u32x4 p = br != 0 ? pw[m][bj] : (u32x4){0u, 0u, 0u, 0u};
                    u32x4 w;
                    w.x = pk2(bf2f(p.x & 0xffffu) + bf2f(g.x & 0xffffu) * v0[0], bf2f(p.x >> 16) + bf2f(g.x >> 16) * v0[1]);
                    w.y = pk2(bf2f(p.y & 0xffffu) + bf2f(g.y & 0xffffu) * v0[2], bf2f(p.y >> 16) + bf2f(g.y >> 16) * v0[3]);
                    w.z = pk2(bf2f(p.z & 0xffffu) + bf2f(g.z & 0xffffu) * v1[0], bf2f(p.z >> 16) + bf2f(g.z >> 16) * v1[1]);
                    w.w = pk2(bf2f(p.w & 0xffffu) + bf2f(g.w & 0xffffu) * v1[2], bf2f(p.w >> 16) + bf2f(g.w >> 16) * v1[3]);
                    *(u32x4*)(Mg + ((size_t)((row >> 8) * (DM / 64) + (col >> 6)) * 256 + (row & 255)) * 64 + (col & 63)) = w; } }
            asm volatile("" ::: "memory");
        }
    }
};

template <class Epi, class Sched>
__device__ __forceinline__ void gemm_phase(const int tid, LAS unsigned char* lds, const Gemm g, const Sched& S, const Epi& E) {
    const int wid = __builtin_amdgcn_readfirstlane(tid >> 6), lane = tid & 63, wr = wid >> 2, wc = wid & 3, fr = lane & 15, fq = lane >> 4;
    const int K = g.K, nt = K / BK, lda = g.blockedA ? BK : g.lda, ldb = g.blockedB ? BK : K;
    unsigned voffA[2], voffB[2];
#pragma unroll
    for (int i = 0; i < 2; ++i) { int R, C; stage_rc(tid * 16 + i * 8192, R, C); const int Rb = Epi::PERM ? ((R & ~31) + perm32(R & 31)) : R;
        voffA[i] = (unsigned)(R * lda + C) * 2u; voffB[i] = (unsigned)(Rb * ldb + C) * 2u; }
    const size_t kstepA = g.blockedA ? (size_t)BM * BK * 2 : (size_t)(BK * 2), kstepB = g.blockedB ? (size_t)BM * BK * 2 : (size_t)(BK * 2);
    const size_t hstepA = (size_t)HALF * lda * 2, hstepB = (size_t)HALF * ldb * 2;
    const size_t tstepA = g.blockedA ? (size_t)nt * BM * BK * 2 : 2 * hstepA, tstepB = g.blockedB ? (size_t)nt * BM * BK * 2 : 2 * hstepB;
    const unsigned ldsw = (unsigned)wid * 1024u;
    const int aoff = lds_byte(wr * 64 + fr, fq * 8), boff = lds_byte(wc * 32 + fr, fq * 8);
#define PG8_SA(b, h) (((b) * 2 + (h)) * HTB)
#define PG8_SB(b, h) ((4 + (b) * 2 + (h)) * HTB)
#define PG8_STAGE(bufoff, gbase, voff) do { _Pragma("unroll") for (int _i = 0; _i < 2; ++_i) \
        __builtin_amdgcn_global_load_lds((const unsigned*)((const char*)(gbase) + (voff)[_i]), (LAS unsigned*)(lds + (bufoff) + ldsw + _i * 8192), 16, 0, 0); } while (0)
#define PG8_LDA(dst, b, h) do { _Pragma("unroll") for (int m = 0; m < 4; ++m) _Pragma("unroll") for (int k = 0; k < 2; ++k) dst[m][k] = *(const LAS bf16x8*)(lds + PG8_SA(b, h) + aoff + m * 2048 + k * 1024); } while (0)
#define PG8_LDB(dst, b, h) do { _Pragma("unroll") for (int n = 0; n < 2; ++n) _Pragma("unroll") for (int k = 0; k < 2; ++k) dst[n][k] = *(const LAS bf16x8*)(lds + PG8_SB(b, h) + boff + n * 2048 + k * 1024); } while (0)
#define PG8_MMA(ai, bj, At, Bt) do { __builtin_amdgcn_s_setprio(1); _Pragma("unroll") for (int m = 0; m < 4; ++m) _Pragma("unroll") for (int n = 0; n < 2; ++n) _Pragma("unroll") for (int k = 0; k < 2; ++k) \
        acc[ai][bj][m][n] = __builtin_amdgcn_mfma_f32_16x16x32_bf16(Bt[n][k], At[m][k], acc[ai][bj][m][n], 0, 0, 0); __builtin_amdgcn_s_setprio(0); } while (0)
#define PG8_WAIT_V(n) asm volatile("s_waitcnt vmcnt(" #n ")" ::: "memory")
#define PG8_WAIT_L(n) asm volatile("s_waitcnt lgkmcnt(" #n ")" ::: "memory")
#define PG8_BAR __builtin_amdgcn_s_barrier()
#define PG8_SCHED __builtin_amdgcn_sched_barrier(0)
    Unit cur, nxt; int ui = 0;
    if (!S.next(0, cur)) return;
    f32x4 acc[2][2][4][2];
#pragma unroll
    for (int a = 0; a < 2; ++a)
#pragma unroll
        for (int b = 0; b < 2; ++b)
#pragma unroll
            for (int m = 0; m < 4; ++m)
#pragma unroll
                for (int n = 0; n < 2; ++n) acc[a][b][m][n] = (f32x4){0.f, 0.f, 0.f, 0.f};
    bf16x8 At[4][2], B0[2][2], B1[2][2];
    const char* cA = (const char*)g.A + (size_t)cur.pm * tstepA; const char* cB = (const char*)g.Bt + (size_t)cur.pn * tstepB;
    PG8_STAGE(PG8_SB(0, 0), cB, voffB); PG8_STAGE(PG8_SB(0, 1), cB + hstepB, voffB); PG8_STAGE(PG8_SA(0, 0), cA, voffA); PG8_STAGE(PG8_SA(0, 1), cA + hstepA, voffA);
    if (wr == 1) PG8_BAR;
    PG8_WAIT_V(2); PG8_BAR;
    PG8_STAGE(PG8_SB(1, 0), cB + kstepB, voffB); PG8_STAGE(PG8_SA(1, 0), cA + kstepA, voffA); PG8_STAGE(PG8_SB(1, 1), cB + hstepB + kstepB, voffB);
    PG8_WAIT_V(6); PG8_BAR;
    for (;;) {
        const bool has_next = S.next(ui + 1, nxt);
        const char* nA = has_next ? (const char*)g.A + (size_t)nxt.pm * tstepA : cA; const char* nB = has_next ? (const char*)g.Bt + (size_t)nxt.pn * tstepB : cB;
        for (int t = 0; t < nt; t += 2) {
            const bool last = (t == nt - 2);
            const char* a1 = cA + (size_t)(t + 1) * kstepA;
            const char* a2 = last ? nA : cA + (size_t)(t + 2) * kstepA; const char* b2 = last ? nB : cB + (size_t)(t + 2) * kstepB;
            const char* a3 = a2 + kstepA; const char* b3 = b2 + kstepB;
            PG8_LDB(B0, 0, 0); PG8_LDB(B1, 0, 1); PG8_SCHED; PG8_LDA(At, 0, 0); PG8_STAGE(PG8_SA(1, 1), a1 + hstepA, voffA);
            PG8_WAIT_V(8); PG8_WAIT_L(0); PG8_BAR; PG8_MMA(0, 0, At, B0); PG8_MMA(0, 1, At, B1); PG8_BAR; PG8_SCHED;
            PG8_LDA(At, 0, 1); PG8_STAGE(PG8_SB(0, 0), b2, voffB); PG8_STAGE(PG8_SB(0, 1), b2 + hstepB, voffB); PG8_STAGE(PG8_SA(0, 0), a2, voffA);
            PG8_WAIT_V(8); PG8_WAIT_L(0); PG8_BAR; PG8_MMA(1, 0, At, B0); PG8_MMA(1, 1, At, B1); PG8_BAR; PG8_SCHED;
            PG8_LDB(B0, 1, 0); PG8_LDB(B1, 1, 1); PG8_SCHED; PG8_LDA(At, 1, 0); PG8_STAGE(PG8_SA(0, 1), a2 + hstepA, voffA);
            PG8_WAIT_V(8); PG8_WAIT_L(0); PG8_BAR; PG8_MMA(0, 0, At, B0); PG8_MMA(0, 1, At, B1); PG8_BAR; PG8_SCHED;
            PG8_LDA(At, 1, 1); PG8_STAGE(PG8_SB(1, 0), b3, voffB); PG8_STAGE(PG8_SB(1, 1), b3 + hstepB, voffB); PG8_STAGE(PG8_SA(1, 0), a3, voffA);
            PG8_WAIT_V(8); PG8_WAIT_L(0); PG8_BAR; PG8_MMA(1, 0, At, B0); PG8_MMA(1, 1, At, B1); PG8_BAR; PG8_SCHED;
        }
        if (wr == 0) PG8_BAR;
        E(acc, cur, wr, wc, fr, fq);
        if (!has_next) break;
#pragma unroll
        for (int a = 0; a < 2; ++a)
#pragma unroll
            for (int b = 0; b < 2; ++b)
#pragma unroll
                for (int m = 0; m < 4; ++m)
#pragma unroll
                    for (int n = 0; n < 2; ++n) acc[a][b][m][n] = (f32x4){0.f, 0.f, 0.f, 0.f};
        cur = nxt; cA = nA; cB = nB; ++ui;
        if (wr == 1) PG8_BAR;
    }
    PG8_WAIT_V(0);
    PG8_BAR;
#undef PG8_SA
#undef PG8_SB
#undef PG8_STAGE
#undef PG8_LDA
#undef PG8_LDB
#undef PG8_MMA
#undef PG8_WAIT_V
#undef PG8_WAIT_L
#undef PG8_BAR
#undef PG8_SCHED
}
}

constexpr int NWAVES = 8, NTHREADS = 512;
constexpr int LDS_BYTES = 147456;
struct Ctx { int tid, lane, wave, gw, ngw, bx, G, l; unsigned char* ws; unsigned char* lds; };
__device__ __forceinline__ Ctx make_ctx(const unsigned char* ws_, unsigned char* lds, int l) {
    Ctx c; int tid = threadIdx.x; asm volatile("" : "+v"(tid));
    int bx = blockIdx.x, G = gridDim.x; asm volatile("" : "+s"(bx), "+s"(G), "+s"(l));
    unsigned long long w = (unsigned long long)ws_; asm volatile("" : "+s"(w));
    c.tid = tid; c.lane = tid & 63; c.wave = __builtin_amdgcn_readfirstlane(tid >> 6); c.bx = bx; c.G = G; c.l = l;
    c.gw = bx * NWAVES + c.wave; c.ngw = G * NWAVES; c.ws = (unsigned char*)(__attribute__((address_space(1))) unsigned char*)w; c.lds = lds; return c;
}

__device__ __forceinline__ int tr_matrix(const Ctx& C, const float* __restrict__ W, int ldn, int nsrc0, int width, int K, bf16_t* __restrict__ WT, int drow0, int mode, int rot) {
    const int nkb = K / 64, nnb = (width + 31) / 32, nitems = nkb * nnb;
    const int kc = C.lane & 7, ng = C.lane >> 3;
    int first = C.gw - (rot % C.ngw); if (first < 0) first += C.ngw;
    for (int it = first; it < nitems; it += C.ngw) {
        const int nb = it % nnb, kb = it / nnb, k0 = 64 * kb + 8 * kc, n = nb * 32 + 4 * ng;
        if (n < width) {
            const float* src = W + (size_t)k0 * ldn + nsrc0 + n;
            f32x4 v[8];
#pragma unroll
            for (int i = 0; i < 8; ++i) v[i] = __builtin_nontemporal_load((const f32x4*)(src + (size_t)i * ldn));
#pragma unroll
            for (int j = 0; j < 4; ++j) {
                const int nn = n + j, dr = (mode & 3) == 0 ? drow0 + nn : (256 * (nn >> 7) + (nn & 127) + ((mode & 3) == 2 ? 128 : 0));
                u32x4 o; o.x = pk2(v[0][j], v[1][j]); o.y = pk2(v[2][j], v[3][j]); o.z = pk2(v[4][j], v[5][j]); o.w = pk2(v[6][j], v[7][j]);
                bf16_t* dst = (mode & 4) ? WT + ((size_t)((dr >> 8) * nkb + kb) * 256 + (dr & 255)) * 64 + 8 * kc : WT + (size_t)dr * K + k0;
                *(u32x4*)dst = o; }
        }
    }
    return rot + nitems;
}
__device__ __forceinline__ void rms_rows(const Ctx& C, const float* __restrict__ x, const float* __restrict__ w, bf16_t* __restrict__ o) {
    f32x4 wv[8];
#pragma unroll
    for (int j = 0; j < 8; ++j) wv[j] = ((const f32x4*)w)[C.lane + 64 * j];
#pragma unroll 2
    for (int row = C.gw; row < T; row += C.ngw) {
        const f32x4* xr = (const f32x4*)(x + (size_t)row * DM) + C.lane; f32x4 v[8]; float s = 0.f;
#pragma unroll
        for (int j = 0; j < 8; ++j) { v[j] = xr[64 * j]; s += (v[j].x * v[j].x + v[j].y * v[j].y) + (v[j].z * v[j].z + v[j].w * v[j].w); }
        const float r = rsqrtf(wave_sum(s) * (1.f / DM) + 1e-6f);
#pragma unroll
        for (int j = 0; j < 8; ++j) { u32x2 q; q.x = pk2(v[j].x * r * wv[j].x, v[j].y * r * wv[j].y); q.y = pk2(v[j].z * r * wv[j].z, v[j].w * r * wv[j].w);
            const int col = 4 * (C.lane + 64 * j);
            *(u32x2*)(o + ((size_t)((row >> 8) * (DM / 64) + (col >> 6)) * 256 + (row & 255)) * 64 + (col & 63)) = q; }
    }
}

#define MFMA32(a, b, c) __builtin_amdgcn_mfma_f32_32x32x16_bf16((a), (b), (c), 0, 0, 0)
template <int DQK, int DV, int MODE, int VR>
__device__ __forceinline__ void attn_unit(const int tid, unsigned char* lds, const bf16_t* __restrict__ Qp, int ldq, const bf16_t* __restrict__ Kp, int ldk, const bf16_t* __restrict__ Vtp,
                                          const float* __restrict__ a2, float cscale, bf16_t* Op, int ldo, int qb, const float* __restrict__ Sprev, int vr0) {
    constexpr int KSTR = DQK * 2 + 16, VSTR = 64 * 2 + 16, KBYTES = 64 * KSTR, VBYTES = DV * VSTR, STG = KBYTES + VBYTES + 256;
    constexpr int NKS = DQK / 16, NBLK = DV / 32, KCH = DQK / 64, VCH = (DV * 8 + 511) / 512, KCPR = DQK / 8;
    static_assert(2 * STG <= 131072, "lds");
    const int lane = tid & 63, r32 = lane & 31, hi = lane >> 5, wid = __builtin_amdgcn_readfirstlane(tid >> 6);
    const int t0 = qb * 256 + wid * 32, t = t0 + r32;
    bf16x8 qf[NKS];
#pragma unroll
    for (int ks = 0; ks < NKS; ++ks) qf[ks] = *(const bf16x8*)(Qp + (size_t)t * ldq + 16 * ks + 8 * hi);
    f32x16 o[NBLK];
#pragma unroll
    for (int b = 0; b < NBLK; ++b)
#pragma unroll
        for (int r = 0; r < 16; ++r) o[b][r] = 0.f;
    float mrun = -INFINITY, lrun = 0.f;
    const float a2t = (MODE == 1) ? a2[t] : 0.f;
    const int ntiles = 4 * qb + 4, jfirst = (MODE == 1) ? 4 * qb : 0;
    const int pirow = 16 * (r32 >> 4) + 8 * ((r32 >> 2) & 1) + 4 * ((r32 >> 3) & 1) + (r32 & 3);
    u32x4 kreg[KCH], vreg[VCH]; f32x4 areg;
#define AT_IDX() int tl_ = tid; asm volatile("" : "+v"(tl_))
#define AT_KROW(i) ((tl_ + 512 * (i)) / KCPR)
#define AT_KCC(i)  ((tl_ + 512 * (i)) % KCPR)
#define AT_VCC(i)  ((tl_ + 512 * (i)) / DV)
#define AT_VDL(i)  ((((tl_ + 512 * (i)) % DV) % (DV / 2)) * 2 + ((tl_ + 512 * (i)) % DV) / (DV / 2))
#define AT_VOK(i)  ((tl_ + 512 * (i)) < DV * 8)
#define AT_LOAD(j) do { const int kv0_ = 64 * (j); AT_IDX(); \
    _Pragma("unroll") for (int i = 0; i < KCH; ++i) kreg[i] = *(const u32x4*)(Kp + (size_t)(kv0_ + AT_KROW(i)) * ldk + AT_KCC(i) * 8); \
    _Pragma("unroll") for (int i = 0; i < VCH; ++i) if (AT_VOK(i)) { const int d_ = vr0 + AT_VDL(i); vreg[i] = *(const u32x4*)(Vtp + (size_t)kv0_ * VR + (AT_VCC(i) * VR + (d_ >> 1) + (d_ & 1) * (VR / 2)) * 8); } \
    if (MODE == 1 && tid < 16) areg = *(const f32x4*)(a2 + kv0_ + tid * 4); } while (0)
#define AT_STORE(buf) do { unsigned char* b_ = lds + (buf) * STG; AT_IDX(); \
    _Pragma("unroll") for (int i = 0; i < KCH; ++i) *(u32x4*)(b_ + AT_KROW(i) * KSTR + AT_KCC(i) * 16) = kreg[i]; \
    _Pragma("unroll") for (int i = 0; i < VCH; ++i) if (AT_VOK(i)) *(u32x4*)(b_ + KBYTES + AT_VDL(i) * VSTR + AT_VCC(i) * 16) = vreg[i]; \
    if (MODE == 1 && tid < 16) *(f32x4*)(b_ + KBYTES + VBYTES + tid * 16) = areg; } while (0)
    if constexpr (MODE == 0) {
        static_assert(KBYTES % 1024 == 0 && VBYTES % 1024 == 0 && KBYTES / 1024 + VBYTES / 1024 <= 48 && 3 * STG + 5 * 1024 <= 147456, "LDS-DMA piece map");
        constexpr int NKP = KBYTES / 1024, NVP = VBYTES / 1024;
        LAS unsigned char* ldsl = (LAS unsigned char*)lds;
        unsigned goff[6];
#pragma unroll
        for (int i = 0; i < 6; ++i) { const int pc = wid + 8 * i, X = pc * 1024 + lane * 16;
            if (pc < NKP) { const int row = X / KSTR; int cb = X % KSTR; if (cb >= DQK * 2) cb = 0; goff[i] = (unsigned)(row * ldk * 2 + cb); }
            else if (pc < NKP + NVP) { const int Y = X - KBYTES, dl = Y / VSTR; int ch = (Y % VSTR) >> 4; if (ch >= 8) ch = 0; const int d = vr0 + dl;
                goff[i] = (unsigned)((ch * VR + (d >> 1) + (d & 1) * (VR / 2)) * 16); }
            else goff[i] = 0u; }
#define AT_DMA(jj) do { const int bb_ = (jj) % 3; \
        _Pragma("unroll") for (int i = 0; i < 6; ++i) { const int pc = wid + 8 * i; \
            const char* src_ = pc < NKP ? (const char*)Kp + (size_t)(jj) * 64 * ldk * 2 + goff[i] : (pc < NKP + NVP ? (const char*)Vtp + (size_t)(jj) * 64 * VR * 2 + goff[i] : (const char*)Kp); \
            const int dst_ = pc < NKP + NVP ? bb_ * STG + pc * 1024 : 3 * STG + (pc - NKP - NVP) * 1024; \
            __builtin_amdgcn_global_load_lds((const unsigned*)src_, (LAS unsigned*)(ldsl + dst_), 16, 0, 0); } } while (0)
        AT_DMA(0); AT_DMA(1);
        asm volatile("s_waitcnt vmcnt(6)" ::: "memory"); __builtin_amdgcn_s_barrier(); asm volatile("" ::: "memory");
        for (int j = 0; j < ntiles; ++j) {
            if (j + 2 < ntiles) AT_DMA(j + 2);
            const int kv0 = 64 * j;
            if (kv0 <= t0 + 31) {
                const unsigned char* Kl = lds + (j % 3) * STG; const unsigned char* Vl = Kl + KBYTES;
                const bool diag = (kv0 + 63 > t0);
                f32x16 p[2];
#pragma unroll
                for (int kb = 0; kb < 2; ++kb)
#pragma unroll
                    for (int r = 0; r < 16; ++r) p[kb][r] = 0.f;
                {
                    constexpr int NS = 2 * NKS;
                    const unsigned char* kb0 = Kl + pirow * KSTR + 16 * hi;
#define AT_KF(i) (*(const bf16x8*)(kb0 + ((i) & 1) * 32 * KSTR + ((i) >> 1) * 32))
                    bf16x8 af[3]; af[0] = AT_KF(0); af[1] = AT_KF(1);
#pragma unroll
                    for (int i = 0; i < NS; ++i) { if (i + 2 < NS) af[(i + 2) % 3] = AT_KF(i + 2); p[i & 1] = MFMA32(af[i % 3], qf[i >> 1], p[i & 1]); }
#undef AT_KF
                    __builtin_amdgcn_sched_group_barrier(0x100, 2, 0);
#pragma unroll
                    for (int i = 0; i < NS - 2; ++i) { __builtin_amdgcn_sched_group_barrier(0x100, 1, 0); __builtin_amdgcn_sched_group_barrier(0x8, 1, 0); }
                    __builtin_amdgcn_sched_group_barrier(0x8, 2, 0);
                }
                if (diag) {
#pragma unroll
                    for (int kb = 0; kb < 2; ++kb)
#pragma unroll
                        for (int r = 0; r < 16; ++r) { const int kv = kv0 + 32 * kb + 16 * (r >> 3) + 8 * hi + (r & 7); if (kv > t) p[kb][r] = -INFINITY; }
                }
                float mx = fmaxf(p[0][0], p[1][0]);
#pragma unroll
                for (int r = 1; r < 16; ++r) mx = fmaxf(mx, fmaxf(p[0][r], p[1][r]));
                mx = fmaxf(mx, __shfl_xor(mx, 32));
                const float mnew = fmaxf(mrun, mx * cscale), alpha = ex2(mrun - mnew); float ls = 0.f;
#pragma unroll
                for (int kb = 0; kb < 2; ++kb)
#pragma unroll
                    for (int r = 0; r < 16; ++r) { const float e = ex2(p[kb][r] * cscale - mnew); p[kb][r] = e; ls += e; }
                lrun = lrun * alpha + ls;
                if (__any(mnew > mrun)) {
#pragma unroll
                    for (int b = 0; b < NBLK; ++b)
#pragma unroll
                        for (int r = 0; r < 16; ++r) o[b][r] *= alpha;
                }
                mrun = mnew;
                bf16x8 pb[2][2];
#pragma unroll
                for (int kb = 0; kb < 2; ++kb)
#pragma unroll
                    for (int sl = 0; sl < 2; ++sl) { u32x4 w; w.x = pk2(p[kb][8 * sl + 0], p[kb][8 * sl + 1]); w.y = pk2(p[kb][8 * sl + 2], p[kb][8 * sl + 3]); w.z = pk2(p[kb][8 * sl + 4], p[kb][8 * sl + 5]); w.w = pk2(p[kb][8 * sl + 6], p[kb][8 * sl + 7]);
                        pb[kb][sl] = __builtin_bit_cast(bf16x8, w); }
                {
                    constexpr int NP = 4 * NBLK;
                    const unsigned char* vb0 = Vl + r32 * VSTR + 16 * hi;
#define AT_VF(i) (*(const bf16x8*)(vb0 + ((i) % NBLK) * 32 * VSTR + ((i) / NBLK) * 32))
                    bf16x8 vf[3]; vf[0] = AT_VF(0); vf[1] = AT_VF(1);
#pragma unroll
                    for (int i = 0; i < NP; ++i) { if (i + 2 < NP) vf[(i + 2) % 3] = AT_VF(i + 2); o[i % NBLK] = MFMA32(vf[i % 3], pb[(i / NBLK) >> 1][(i / NBLK) & 1], o[i % NBLK]); }
#undef AT_VF
                    __builtin_amdgcn_sched_group_barrier(0x100, 2, 1);
#pragma unroll
                    for (int i = 0; i < NP - 2; ++i) { __builtin_amdgcn_sched_group_barrier(0x100, 1, 1); __builtin_amdgcn_sched_group_barrier(0x8, 1, 1); }
                    __builtin_amdgcn_sched_group_barrier(0x8, 2, 1);
                }
            }
            if (j + 2 < ntiles) asm volatile("s_waitcnt vmcnt(6) lgkmcnt(0)" ::: "memory"); else asm volatile("s_waitcnt vmcnt(0) lgkmcnt(0)" ::: "memory");
            __builtin_amdgcn_s_barrier(); asm volatile("" ::: "memory");
        }
#undef AT_DMA
    } else {
    AT_LOAD(jfirst);
    if (MODE == 1 && qb > 0) {
        constexpr int SSTR = DQK * 2 + 16, SP_OFF = STG, NLD = DV * DQK / 4 / 512;
        static_assert(SP_OFF + DV * SSTR <= 147456, "Sprev staging");
#pragma unroll 4
        for (int i = 0; i < NLD; ++i) { const int idx = tid + 512 * i, e = idx / (DQK / 4), c4 = idx % (DQK / 4);
            const f32x4 v = *(const f32x4*)(Sprev + (size_t)e * DQK + 4 * c4);
            u32x2 w; w.x = pk2(v[0], v[1]); w.y = pk2(v[2], v[3]);
            *(u32x2*)(lds + SP_OFF + e * SSTR + c4 * 8) = w; }
        __syncthreads();
#pragma unroll
        for (int b = 0; b < NBLK; ++b)
#pragma unroll
            for (int ks = 0; ks < NKS; ++ks) { const bf16x8 a = *(const bf16x8*)(lds + SP_OFF + (32 * b + r32) * SSTR + (16 * ks + 8 * hi) * 2); o[b] = MFMA32(a, qf[ks], o[b]); }
        const float dq = ex2(a2t - a2[qb * 256 - 1]);
#pragma unroll
        for (int b = 0; b < NBLK; ++b)
#pragma unroll
            for (int r = 0; r < 16; ++r) o[b][r] *= dq;
    }
    AT_STORE(jfirst & 1);
    __syncthreads();
    for (int j = jfirst; j < ntiles; ++j) {
        if (j + 1 < ntiles) AT_LOAD(j + 1);
        const int kv0 = 64 * j;
        if (kv0 <= t0 + 31) {
            const unsigned char* Kl = lds + (j & 1) * STG; const unsigned char* Vl = Kl + KBYTES; const float* Al = (const float*)(Vl + VBYTES);
            const bool diag = (kv0 + 63 > t0);
            if (MODE == 0) {
                f32x16 p[2];
#pragma unroll
                for (int kb = 0; kb < 2; ++kb)
#pragma unroll
                    for (int r = 0; r < 16; ++r) p[kb][r] = 0.f;
                {
                    constexpr int NS = 2 * NKS;
                    const unsigned char* kb0 = Kl + pirow * KSTR + 16 * hi;
#define AT_KF(i) (*(const bf16x8*)(kb0 + ((i) & 1) * 32 * KSTR + ((i) >> 1) * 32))
                    bf16x8 af[3]; af[0] = AT_KF(0); af[1] = AT_KF(1);
#pragma unroll
                    for (int i = 0; i < NS; ++i) { if (i + 2 < NS) af[(i + 2) % 3] = AT_KF(i + 2); p[i & 1] = MFMA32(af[i % 3], qf[i >> 1], p[i & 1]); }
#undef AT_KF
                    __builtin_amdgcn_sched_group_barrier(0x100, 2, 0);
#pragma unroll
                    for (int i = 0; i < NS - 2; ++i) { __builtin_amdgcn_sched_group_barrier(0x100, 1, 0); __builtin_amdgcn_sched_group_barrier(0x8, 1, 0); }
                    __builtin_amdgcn_sched_group_barrier(0x8, 2, 0);
                }
                if (diag) {
#pragma unroll
                    for (int kb = 0; kb < 2; ++kb)
#pragma unroll
                        for (int r = 0; r < 16; ++r) { const int kv = kv0 + 32 * kb + 16 * (r >> 3) + 8 * hi + (r & 7); if (kv > t) p[kb][r] = -INFINITY; }
                }
                float mx = fmaxf(p[0][0], p[1][0]);
#pragma unroll
                for (int r = 1; r < 16; ++r) mx = fmaxf(mx, fmaxf(p[0][r], p[1][r]));
                mx = fmaxf(mx, __shfl_xor(mx, 32));
                const float mnew = fmaxf(mrun, mx * cscale), alpha = ex2(mrun - mnew); float ls = 0.f;
#pragma unroll
                for (int kb = 0; kb < 2; ++kb)
#pragma unroll
                    for (int r = 0; r < 16; ++r) { const float e = ex2(p[kb][r] * cscale - mnew); p[kb][r] = e; ls += e; }
                lrun = lrun * alpha + ls;
                if (__any(mnew > mrun)) {
#pragma unroll
                    for (int b = 0; b < NBLK; ++b)
#pragma unroll
                        for (int r = 0; r < 16; ++r) o[b][r] *= alpha;
                }
                mrun = mnew;
                bf16x8 pb[2][2];
#pragma unroll
                for (int kb = 0; kb < 2; ++kb)
#pragma unroll
                    for (int sl = 0; sl < 2; ++sl) { u32x4 w; w.x = pk2(p[kb][8 * sl + 0], p[kb][8 * sl + 1]); w.y = pk2(p[kb][8 * sl + 2], p[kb][8 * sl + 3]); w.z = pk2(p[kb][8 * sl + 4], p[kb][8 * sl + 5]); w.w = pk2(p[kb][8 * sl + 6], p[kb][8 * sl + 7]);
                        pb[kb][sl] = __builtin_bit_cast(bf16x8, w); }
                {
                    constexpr int NP = 4 * NBLK;
                    const unsigned char* vb0 = Vl + r32 * VSTR + 16 * hi;
#define AT_VF(i) (*(const bf16x8*)(vb0 + ((i) % NBLK) * 32 * VSTR + ((i) / NBLK) * 32))
                    bf16x8 vf[3]; vf[0] = AT_VF(0); vf[1] = AT_VF(1);
#pragma unroll
                    for (int i = 0; i < NP; ++i) { if (i + 2 < NP) vf[(i + 2) % 3] = AT_VF(i + 2); o[i % NBLK] = MFMA32(vf[i % 3], pb[(i / NBLK) >> 1][(i / NBLK) & 1], o[i % NBLK]); }
#undef AT_VF
                    __builtin_amdgcn_sched_group_barrier(0x100, 2, 1);
#pragma unroll
                    for (int i = 0; i < NP - 2; ++i) { __builtin_amdgcn_sched_group_barrier(0x100, 1, 1); __builtin_amdgcn_sched_group_barrier(0x8, 1, 1); }
                    __builtin_amdgcn_sched_group_barrier(0x8, 2, 1);
                }
            } else {
#pragma unroll
                for (int kb = 0; kb < 2; ++kb) {
                    if (kv0 + 32 * kb > t0 + 31) continue;
                    f32x16 p;
#pragma unroll
                    for (int r = 0; r < 16; ++r) p[r] = 0.f;
#pragma unroll
                    for (int ks = 0; ks < NKS; ++ks) { const bf16x8 a = *(const bf16x8*)(Kl + (32 * kb + pirow) * KSTR + (16 * ks + 8 * hi) * 2); p = MFMA32(a, qf[ks], p); }
                    bf16x8 pb[2];
#pragma unroll
                    for (int sl = 0; sl < 2; ++sl) {
                        const f32x4 s0 = *(const f32x4*)(Al + 32 * kb + 16 * sl + 8 * hi), s1 = *(const f32x4*)(Al + 32 * kb + 16 * sl + 8 * hi + 4);
                        float e[8];
#pragma unroll
                        for (int jj = 0; jj < 8; ++jj) { const float as = jj < 4 ? s0[jj] : s1[jj - 4]; const int kv = kv0 + 32 * kb + 16 * sl + 8 * hi + jj;
                            const float w = ex2(a2t - as); e[jj] = (diag && kv > t) ? 0.f : p[8 * sl + jj] * w; }
                        u32x4 w; w.x = pk2(e[0], e[1]); w.y = pk2(e[2], e[3]); w.z = pk2(e[4], e[5]); w.w = pk2(e[6], e[7]);
                        pb[sl] = __builtin_bit_cast(bf16x8, w);
                    }
#pragma unroll
                    for (int b = 0; b < NBLK; ++b)
#pragma unroll
                        for (int sl = 0; sl < 2; ++sl) { const bf16x8 a = *(const bf16x8*)(Vl + (32 * b + r32) * VSTR + (32 * kb + 16 * sl + 8 * hi) * 2); o[b] = MFMA32(a, pb[sl], o[b]); }
                }
            }
        }
        if (j + 1 < ntiles) AT_STORE((j + 1) & 1);
        __syncthreads();
    }
    }
#undef AT_LOAD
#undef AT_STORE
    float inv = 1.f;
    if (MODE == 0) { lrun += __shfl_xor(lrun, 32); inv = 1.f / lrun; }
    {
        constexpr int OSTR = DV * 2 + 16, CPR = DV / 8;
        unsigned char* stg = lds + wid * (32 * OSTR);
#pragma unroll
        for (int b = 0; b < NBLK; ++b)
#pragma unroll
            for (int g = 0; g < 4; ++g) { u32x2 w; w.x = pk2(o[b][4 * g] * inv, o[b][4 * g + 1] * inv); w.y = pk2(o[b][4 * g + 2] * inv, o[b][4 * g + 3] * inv);
                *(u32x2*)(stg + r32 * OSTR + (32 * b + 8 * g + 4 * hi) * 2) = w; }
        asm volatile("s_waitcnt lgkmcnt(0)" ::: "memory");
#pragma unroll
        for (int i = 0; i < DV / 16; ++i) { const int id = lane + 64 * i, row = id / CPR, ch = id % CPR;
            const u32x4 v = *(const u32x4*)(stg + row * OSTR + ch * 16);
            *(u32x4*)(Op + (size_t)(t0 + row) * ldo + ch * 8) = v; }
    }
}

#define XB_TMO      128
#define XB_XCNT(j)  (256  + 64 * (j))
#define XB_XSUB(j)  (1280 + 64 * (j))
#define XB_XGEN(j)  (2304 + 64 * (j))
#define XB_TOP      3328
#define XB_TOPGEN   3392
#define XCD_BAR_WORDS 3456
#define XB_SPIN_CAP (1u << 18)
__device__ __forceinline__ unsigned xb_ld(unsigned* p)              { return __hip_atomic_load(p, __ATOMIC_RELAXED, __HIP_MEMORY_SCOPE_AGENT); }
__device__ __forceinline__ unsigned xb_add(unsigned* p, unsigned v) { return __hip_atomic_fetch_add(p, v, __ATOMIC_RELAXED, __HIP_MEMORY_SCOPE_AGENT); }
__device__ __forceinline__ unsigned xb_xcc_id() { return (unsigned)__builtin_amdgcn_s_getreg((3 << 11) | 20) & 0xFu; }
#define XB_SPIN(cond, bar) do { unsigned _sp = 0; while (cond) { __builtin_amdgcn_s_sleep(1); \
    if ((++_sp & 255u) == 0u) { if (xb_ld(&(bar)[XB_TMO])) break; if (_sp > XB_SPIN_CAP) { atomicAdd(&(bar)[XB_TMO], 1u); break; } } } } while (0)
struct XcdBarrier { unsigned* bar; unsigned x; volatile LAS unsigned* st; };
__device__ __forceinline__ XcdBarrier xcd_barrier_post(unsigned* bar, volatile LAS unsigned* st) {
    XcdBarrier b; b.bar = bar; b.x = xb_xcc_id(); b.st = st;
    if (threadIdx.x == 0) (void)xb_add(&bar[XB_XCNT(b.x)], 1u);
    return b;
}
__device__ __forceinline__ void xcd_barrier_complete(unsigned* bar, unsigned x, unsigned& nloc, unsigned& nx) {
    const unsigned G = gridDim.x * gridDim.y * gridDim.z;
    unsigned sum, cnt, mine, sp = 0u;
    for (;;) {
        sum = 0u; cnt = 0u; mine = 0u;
#pragma unroll
        for (unsigned j = 0; j < 16; ++j) { const unsigned c = xb_ld(&bar[XB_XCNT(j)]); sum += c; cnt += (c > 0u) ? 1u : 0u; mine = (j == x) ? c : mine; }
        if (sum == G) break;
        __builtin_amdgcn_s_sleep(1);
        if ((++sp & 255u) == 0u) { if (xb_ld(&bar[XB_TMO])) break; if (sp > XB_SPIN_CAP) { atomicAdd(&bar[XB_TMO], 1u); break; } }
    }
    nloc = mine > 0u ? mine : 1u; nx = cnt > 0u ? cnt : 1u;
}
__device__ __forceinline__ void xcd_barrier(const XcdBarrier& b) {
    asm volatile("s_waitcnt vmcnt(0)" ::: "memory");
    __syncthreads();
    if (threadIdx.x == 0) {
        unsigned* bar = b.bar;
        __builtin_amdgcn_s_waitcnt(0);
        unsigned nloc = b.st[0], nx = b.st[1];
        if (nloc == 0u) { xcd_barrier_complete(bar, b.x, nloc, nx); b.st[0] = nloc; b.st[1] = nx; }
        const unsigned old = xb_add(&bar[XB_XSUB(b.x)], 1u);
        const unsigned gen = old / nloc;
        if (old + 1u == (gen + 1u) * nloc) {
            __builtin_amdgcn_fence(__ATOMIC_RELEASE, "agent");
            asm volatile("s_waitcnt vmcnt(0)" ::: "memory");
            const unsigned og = xb_add(&bar[XB_TOP], 1u);
            const unsigned tg = og / nx;
            if (og + 1u == (tg + 1u) * nx) xb_add(&bar[XB_TOPGEN], 1u);
            else XB_SPIN(xb_ld(&bar[XB_TOPGEN]) == tg, bar);
            __builtin_amdgcn_fence(__ATOMIC_ACQUIRE, "agent");
            xb_add(&bar[XB_XGEN(b.x)], 1u);
            asm volatile("s_waitcnt vmcnt(0)" ::: "memory");
        } else {
            XB_SPIN(xb_ld(&bar[XB_XGEN(b.x)]) == gen, bar);
            __builtin_amdgcn_fence(__ATOMIC_ACQUIRE, "agent");
            asm volatile("s_waitcnt vmcnt(0)" ::: "memory");
        }
    }
    __syncthreads();
}

#define WSP(T_, off) ((T_*)(C.ws + (off)))
#define PH_FN __device__ __forceinline__ void

PH_FN ph_ffn_prep(const Params& prm, unsigned char* lds, int l_, int ffn) {
    const Ctx C = make_ctx(prm.ws, lds, l_); const int l = C.l;
    const int nb = (ffn == 0) ? 2 : 26;
    const float* xb = (ffn == 0 && l == 0) ? as_global(prm.in[0]) : as_global(prm.out);
    bf16_t* WGU = WSP(bf16_t, WS_BIG + FFW_GU); bf16_t* WDN = WSP(bf16_t, WS_BIG + FFW_DN);
    int rot = 0;
    rot = tr_matrix(C, as_global(prm.in[nb + 1]) + (size_t)l * DM * DFF, DFF, 0, DFF, DM, WGU, 0, 1 | 4, rot);
    rot = tr_matrix(C, as_global(prm.in[nb + 2]) + (size_t)l * DM * DFF, DFF, 0, DFF, DM, WGU, 0, 2 | 4, rot);
    rot = tr_matrix(C, as_global(prm.in[nb + 3]) + (size_t)l * DFF * DM, DM, 0, DM, DFF, WDN, 0, 4, rot);
    rms_rows(C, xb, as_global(prm.in[nb]) + (size_t)l * DM, WSP(bf16_t, WS_H));
}
PH_FN ph_ffn_gu(const Params& prm, unsigned char* lds, int l_) {
    const Ctx C = make_ctx(prm.ws, lds, l_);
    pg8::Gemm g{WSP(bf16_t, WS_H), WSP(bf16_t, WS_BIG + FFW_GU), T, 2 * DFF, DM, DM, 1, 1}; pg8::StaticOrder S; S.init(T, 2 * DFF, C.G, C.bx);
    pg8::EpiSwiGLU E{WSP(bf16_t, WS_BIG + FF_HID), DFF};
    pg8::gemm_phase(C.tid, (LAS unsigned char*)lds, g, S, E);
}
PH_FN ph_ffn_dn(const Params& prm, unsigned char* lds, int l_, int ffn) {
    const Ctx C = make_ctx(prm.ws, lds, l_);
    const float* xb = (ffn == 0 && C.l == 0) ? as_global(prm.in[0]) : as_global(prm.out);
    pg8::Gemm g{WSP(bf16_t, WS_BIG + FF_HID), WSP(bf16_t, WS_BIG + FFW_DN), T, DM, DFF, DFF, 1, 1}; pg8::StaticOrder S; S.init(T, DM, C.G, C.bx);
    pg8::EpiResid E{xb, as_global(prm.out), 0.5f};
    pg8::gemm_phase(C.tid, (LAS unsigned char*)lds, g, S, E);
}
PH_FN ph_m0(const Params& prm, unsigned char* lds, int l_) {
    const Ctx C = make_ctx(prm.ws, lds, l_); const int l = C.l;
    bf16_t* WIN = WSP(bf16_t, WS_WA);
    const float* w_in = as_global(prm.in[7]) + (size_t)l * DM * DIN;
    int rot = 0;
    rot = tr_matrix(C, w_in, DIN, 0, 2560, DM, WIN, Z0, 4, rot);
    rot = tr_matrix(C, w_in, DIN, 2560, 16, DM, WIN, DT0, 4, rot);
    rot = tr_matrix(C, w_in, DIN, 2576, 768, DM, WIN, QL0, 4, rot);
    rot = tr_matrix(C, w_in, DIN, 3344, 576, DM, WIN, KVL0, 4, rot);
    rot = tr_matrix(C, w_in, DIN, 3920, 4096, DM, WIN, RQ0, 4, rot);
    rot = tr_matrix(C, w_in, DIN, 8016, 6144, DM, WIN, GT0, 4, rot);
    for (int i = C.gw * 64 + C.lane; i < 176 * DM / 8; i += C.ngw * 64) { const int kb = i / (176 * 8), rem = i % (176 * 8);
        ((u32x4*)(WIN + ((size_t)(15 * (DM / 64) + kb) * 256 + 80) * 64))[rem] = (u32x4){0u, 0u, 0u, 0u}; }
    rot = tr_matrix(C, as_global(prm.in[16]) + (size_t)l * 768 * 1536, 1536, 0, 1536, 768, WSP(bf16_t, WS_WS + WQB_OFF), 0, 4, rot);
    rot = tr_matrix(C, as_global(prm.in[18]) + (size_t)l * 512 * 2048, 2048, 0, 2048, 512, WSP(bf16_t, WS_WS + WKVB_OFF), 0, 4, rot);
    rot = tr_matrix(C, as_global(prm.in[22]) + (size_t)l * 1024 * 2048, 2048, 0, 2048, 1024, WSP(bf16_t, WS_WS + WBR_OFF), 0, 4, rot);
    rot = tr_matrix(C, as_global(prm.in[23]) + (size_t)l * 1024 * 2048, 2048, 0, 2048, 1024, WSP(bf16_t, WS_WS + WBR_OFF), 2048, 4, rot);
    rot = tr_matrix(C, as_global(prm.in[24]) + (size_t)l * 1024 * 2048, 2048, 0, 2048, 1024, WSP(bf16_t, WS_WS + WBR_OFF), 4096, 4, rot);
    rot = tr_matrix(C, as_global(prm.in[25]) + (size_t)l * 2048 * 2048, 2048, 0, 2048, 2048, WSP(bf16_t, WS_WS + WOUT_OFF), 0, 4, rot);
    rms_rows(C, as_global(prm.out), as_global(prm.in[6]) + (size_t)l * DM, WSP(bf16_t, WS_H));
}
PH_FN ph_m1(const Params& prm, unsigned char* lds, int l_) {
    const Ctx C = make_ctx(prm.ws, lds, l_);
    pg8::Gemm g{WSP(bf16_t, WS_H), WSP(bf16_t, WS_WA), T, NPROJ, DM, DM, 1, 1}; pg8::StaticOrder S; S.init(T, NPROJ, C.G, C.bx);
    pg8::EpiBf16 E{WSP(bf16_t, WS_BIG), LDP, as_global(prm.in[8]) + (size_t)C.l * 3 * DM, GT0, WSP(bf16_t, WS_BIG + GATE_OFF)};
    pg8::gemm_phase(C.tid, (LAS unsigned char*)lds, g, S, E);
}
PH_FN ph_m2a(const Params& prm, unsigned char* lds, int l_) {
    const Ctx C = make_ctx(prm.ws, lds, l_); const int l = C.l;
    const bf16_t* __restrict__ PROJ = WSP(bf16_t, WS_BIG); bf16_t* __restrict__ XS = WSP(bf16_t, WS_H); bf16_t* __restrict__ BC = WSP(bf16_t, WS_H) + (size_t)T * 1024;
    bf16_t* __restrict__ XT = WSP(bf16_t, WS_WA); bf16_t* __restrict__ VTR = WSP(bf16_t, WS_WA) + (size_t)T * 1024; bf16_t* __restrict__ BTS = WSP(bf16_t, WS_H) + (size_t)T * 1536;
    const float* conv_w = as_global(prm.in[9]) + (size_t)l * 4 * 1536; const float* conv_b = as_global(prm.in[10]) + (size_t)l * 1536; const float* dt_bias = as_global(prm.in[11]) + (size_t)l * 16;
    const float* a_log = as_global(prm.in[12]) + (size_t)l * 16; float* A2S = WSP(float, WS_A2S); float* A2BT = WSP(float, WS_A2BT);
    float* dts = (float*)lds;
    for (int ub = C.bx; ub < T / 64; ub += C.G) {
        const int tb = ub * 64, b = tb / SEQ, sl0 = tb % SEQ;
        __syncthreads();
        for (int i = C.tid; i < 1024; i += NTHREADS) { const int tt = i >> 4, h = i & 15;
            const float v = bf2f(PROJ[(size_t)(tb + tt) * LDP + DT0 + h]) + dt_bias[h];
            dts[i] = v > 20.f ? v : log1pf(__expf(v)); }
        __syncthreads();
#pragma unroll
        for (int hh = 0; hh < 2; ++hh) {
            const int h = 2 * C.wave + hh; const float a = -__expf(a_log[h]) * LOG2E;
            float incl = dts[C.lane * 16 + h] * a;
#pragma unroll
            for (int o = 1; o < 64; o <<= 1) { const float n = __shfl_up(incl, o); if (C.lane >= o) incl += n; }
            A2S[(size_t)(b * 16 + h) * SEQ + sl0 + C.lane] = incl;
            if (C.lane == 63) A2BT[(b * 16 + h) * 64 + (sl0 >> 6)] = incl;
        }
        for (int cp = C.tid; cp < 768; cp += NTHREADS) {
            const int c = 2 * cp;
            const f32x2 w0 = *(const f32x2*)(conv_w + c), w1 = *(const f32x2*)(conv_w + 1536 + c), w2 = *(const f32x2*)(conv_w + 3072 + c), w3 = *(const f32x2*)(conv_w + 4608 + c), cb = *(const f32x2*)(conv_b + c);
            f32x2 xm3 = {0.f, 0.f}, xm2 = {0.f, 0.f}, xm1 = {0.f, 0.f};
            const bf16_t* __restrict__ src = PROJ + (size_t)tb * LDP + XBC0 + c;
            if (sl0 > 0) { unsigned u;
                u = *(const unsigned*)(src - 3 * (size_t)LDP); xm3 = (f32x2){bf2f(u & 0xffffu), bf2f(u >> 16)};
                u = *(const unsigned*)(src - 2 * (size_t)LDP); xm2 = (f32x2){bf2f(u & 0xffffu), bf2f(u >> 16)};
                u = *(const unsigned*)(src - 1 * (size_t)LDP); xm1 = (f32x2){bf2f(u & 0xffffu), bf2f(u >> 16)}; }
            const int h = (c >> 6) & 15;
            const bool isx = c < 1024, isb = (c >= 1024 && c < 1280);
            const int rr = isx ? 64 : 128, r0 = isx ? ((c & 63) >> 1) : (((c - 1024) & 127) >> 1);
            bf16_t* __restrict__ d0 = (isx ? XT + (size_t)(b * 16 + h) * 64 * SEQ : BTS + (size_t)(b * 2 + ((c - 1024) >> 7)) * 128 * SEQ) + ((size_t)(sl0 >> 3) * rr + r0) * 8;
            for (int t8 = 0; t8 < 8; ++t8) {
                float e0[8], e1[8];
#pragma unroll
                for (int ti = 0; ti < 8; ++ti) { const int tt = t8 * 8 + ti;
                    const unsigned u = *(const unsigned*)(src + (size_t)tt * LDP); const f32x2 xc = {bf2f(u & 0xffffu), bf2f(u >> 16)};
                    f32x2 y = cb + w0 * xm3 + w1 * xm2 + w2 * xm1 + w3 * xc; xm3 = xm2; xm2 = xm1; xm1 = xc;
                    y.x = siluf_(y.x); y.y = siluf_(y.y);
                    const float d = isx ? dts[tt * 16 + h] : 1.f; e0[ti] = y.x * d; e1[ti] = y.y * d;
                    if (isx) *(unsigned*)(XS + (size_t)(tb + tt) * 1024 + c) = pk2(y.x, y.y);
                    else *(unsigned*)(BC + (size_t)(tb + tt) * 512 + (c - 1024)) = pk2(y.x, y.y); }
                if (isx || isb) {
                    *(u32x4*)(d0 + (size_t)t8 * rr * 8) = (u32x4){pk2(e0[0], e0[1]), pk2(e0[2], e0[3]), pk2(e0[4], e0[5]), pk2(e0[6], e0[7])};
                    *(u32x4*)(d0 + (size_t)t8 * rr * 8 + (rr / 2) * 8) = (u32x4){pk2(e1[0], e1[1]), pk2(e1[2], e1[3]), pk2(e1[4], e1[5]), pk2(e1[6], e1[7])}; }
            }
        }
        {
            const int c = 2 * C.tid, h = c >> 8, e = c & 255;
            const bf16_t* __restrict__ src = PROJ + (size_t)tb * LDP + RV0 + c;
            bf16_t* __restrict__ d0 = VTR + (size_t)(b * 4 + h) * 256 * SEQ + ((size_t)(sl0 >> 3) * 256 + (e >> 1)) * 8;
            for (int t8 = 0; t8 < 8; ++t8) { unsigned u[8];
#pragma unroll
                for (int ti = 0; ti < 8; ++ti) u[ti] = *(const unsigned*)(src + (size_t)(t8 * 8 + ti) * LDP);
                u32x4 lo, hi2;
                lo.x = (u[0] & 0xffffu) | (u[1] << 16); lo.y = (u[2] & 0xffffu) | (u[3] << 16); lo.z = (u[4] & 0xffffu) | (u[5] << 16); lo.w = (u[6] & 0xffffu) | (u[7] << 16);
                hi2.x = (u[0] >> 16) | (u[1] & 0xffff0000u); hi2.y = (u[2] >> 16) | (u[3] & 0xffff0000u); hi2.z = (u[4] >> 16) | (u[5] & 0xffff0000u); hi2.w = (u[6] >> 16) | (u[7] & 0xffff0000u);
                *(u32x4*)(d0 + (size_t)t8 * 256 * 8) = lo; *(u32x4*)(d0 + (size_t)t8 * 256 * 8 + 128 * 8) = hi2; }
        }
    }
}
PH_FN ph_m2b(const Params& prm, unsigned char* lds, int l_) {
    const Ctx C = make_ctx(prm.ws, lds, l_); const int l = C.l;
    bf16_t* PROJ = WSP(bf16_t, WS_BIG); const int* positions = (const int*)as_global(prm.in[1]);
    const float* qan = as_global(prm.in[15]) + (size_t)l * 768; const float* kvan = as_global(prm.in[17]) + (size_t)l * 512;
    f32x4 qw[3], kw0, kw1; float invf[2];
#pragma unroll
    for (int j = 0; j < 3; ++j) qw[j] = *(const f32x4*)(qan + 4 * C.lane + 256 * j);
    kw0 = *(const f32x4*)(kvan + 8 * C.lane); kw1 = *(const f32x4*)(kvan + 8 * C.lane + 4);
#pragma unroll
    for (int e = 0; e < 2; ++e) invf[e] = 1.0f / exp2f((float)(2 * C.lane + e) * (13.287712379549449f / 128.f));
    for (int row = C.gw; row < T; row += C.ngw) {
        bf16_t* pr = PROJ + (size_t)row * LDP;
        u32x2 qu[3]; u32x4 ku; unsigned r1[2][4], r2[2][4];
#pragma unroll
        for (int j = 0; j < 3; ++j) qu[j] = *(const u32x2*)(pr + QL0 + 4 * C.lane + 256 * j);
        ku = *(const u32x4*)(pr + KVL0 + 8 * C.lane);
#pragma unroll
        for (int qk = 0; qk < 2; ++qk)
#pragma unroll
            for (int h = 0; h < 4; ++h) { const bf16_t* p1 = pr + (qk ? RK0 : RQ0) + h * 256 + 2 * C.lane; r1[qk][h] = *(const unsigned*)p1; r2[qk][h] = *(const unsigned*)(p1 + 128); }
        const float pos = (float)positions[row];
        {
            float v[12]; float s = 0.f;
#pragma unroll
            for (int j = 0; j < 3; ++j) { v[4 * j] = bf2f(qu[j].x & 0xffffu); v[4 * j + 1] = bf2f(qu[j].x >> 16); v[4 * j + 2] = bf2f(qu[j].y & 0xffffu); v[4 * j + 3] = bf2f(qu[j].y >> 16); }
            float v2[8];
            v2[0] = bf2f(ku.x & 0xffffu); v2[1] = bf2f(ku.x >> 16); v2[2] = bf2f(ku.y & 0xffffu); v2[3] = bf2f(ku.y >> 16); v2[4] = bf2f(ku.z & 0xffffu); v2[5] = bf2f(ku.z >> 16); v2[6] = bf2f(ku.w & 0xffffu); v2[7] = bf2f(ku.w >> 16);
            float s2 = 0.f;
#pragma unroll
            for (int j = 0; j < 12; ++j) s += v[j] * v[j];
#pragma unroll
            for (int j = 0; j < 8; ++j) s2 += v2[j] * v2[j];
#pragma unroll
            for (int o = 1; o < 64; o <<= 1) { s += __shfl_xor(s, o); s2 += __shfl_xor(s2, o); }
            const float r = rsqrtf(s * (1.f / 768.f) + 1e-6f), rk = rsqrtf(s2 * (1.f / 512.f) + 1e-6f);
#pragma unroll
            for (int j = 0; j < 3; ++j) { const f32x4 w = qw[j]; u32x2 o; o.x = pk2(v[4 * j] * r * w[0], v[4 * j + 1] * r * w[1]); o.y = pk2(v[4 * j + 2] * r * w[2], v[4 * j + 3] * r * w[3]);
                *(u32x2*)(pr + QL0 + 4 * C.lane + 256 * j) = o; }
            u32x4 o; o.x = pk2(v2[0] * rk * kw0[0], v2[1] * rk * kw0[1]); o.y = pk2(v2[2] * rk * kw0[2], v2[3] * rk * kw0[3]); o.z = pk2(v2[4] * rk * kw1[0], v2[5] * rk * kw1[1]); o.w = pk2(v2[6] * rk * kw1[2], v2[7] * rk * kw1[3]);
            *(u32x4*)(pr + KVL0 + 8 * C.lane) = o;
        }
        {
            float cs[2], sn[2];
#pragma unroll
            for (int e = 0; e < 2; ++e) sincos_rev(pos * invf[e], cs[e], sn[e]);
#pragma unroll
            for (int qk = 0; qk < 2; ++qk)
#pragma unroll
                for (int h = 0; h < 4; ++h) { bf16_t* p1 = pr + (qk ? RK0 : RQ0) + h * 256 + 2 * C.lane; const float sc = qk ? 0.0625f : 1.f;
                    const unsigned u1 = r1[qk][h], u2 = r2[qk][h];
                    const float a0 = bf2f(u1 & 0xffffu), a1 = bf2f(u1 >> 16), b0 = bf2f(u2 & 0xffffu), b1 = bf2f(u2 >> 16);
                    *(unsigned*)p1 = pk2((a0 * cs[0] - b0 * sn[0]) * sc, (a1 * cs[1] - b1 * sn[1]) * sc);
                    *(unsigned*)(p1 + 128) = pk2((a0 * sn[0] + b0 * cs[0]) * sc, (a1 * sn[1] + b1 * cs[1]) * sc); }
        }
    }
}
PH_FN ph_m2c(const Params& prm, unsigned char* lds, int l_) {
    const Ctx C = make_ctx(prm.ws, lds, l_); const int l = C.l;
    const bf16_t* PROJ = WSP(bf16_t, WS_BIG); float* A2S = WSP(float, WS_A2S); float* A2R = WSP(float, WS_A2R);
    const float* dt_bias = as_global(prm.in[11]) + (size_t)l * 16; const float* a_log = as_global(prm.in[12]) + (size_t)l * 16;
    if (C.gw < 64) {
    } else if (C.gw < 68) {
        const int h = C.gw - 64; const float lg2 = log2f(1.f - exp2f(-(5.f + 7.f * (float)h / 3.f)));
        for (int i = C.lane; i < SEQ; i += 64) A2R[h * SEQ + i] = (float)i * lg2;
    }
}
PH_FN ph_m3a(const Params& prm, unsigned char* lds, int l_) {
    const Ctx C = make_ctx(prm.ws, lds, l_);
    pg8::Gemm g{WSP(bf16_t, WS_BIG) + QL0, WSP(bf16_t, WS_WS + WQB_OFF), T, 1536, 768, LDP, 0, 1}; pg8::StaticOrder S; S.init(T, 1536, C.G, C.bx);
    pg8::EpiBf16 E{WSP(bf16_t, WS_R1), 1536, nullptr, 0, nullptr};
    pg8::gemm_phase(C.tid, (LAS unsigned char*)lds, g, S, E);
}
PH_FN ph_m3b(const Params& prm, unsigned char* lds, int l_) {
    const Ctx C = make_ctx(prm.ws, lds, l_);
    pg8::Gemm g{WSP(bf16_t, WS_BIG) + KVL0, WSP(bf16_t, WS_WS + WKVB_OFF), T, 2048, 512, LDP, 0, 1}; pg8::StaticOrder S; S.init(T, 2048, C.G, C.bx);
    pg8::EpiBf16 E{WSP(bf16_t, WS_R1) + (size_t)T * 1536, 2048, nullptr, 0, nullptr};
    pg8::gemm_phase(C.tid, (LAS unsigned char*)lds, g, S, E);
}
PH_FN ph_m4a(const Params& prm, unsigned char* lds, int l_) {
    const Ctx C = make_ctx(prm.ws, lds, l_);
    const bf16_t* KVb = WSP(bf16_t, WS_R1) + (size_t)T * 1536; bf16_t* VTM = WSP(bf16_t, WS_R2) + (size_t)2 * T * 8 * 192;
    for (int ub = C.bx; ub < T / 64; ub += C.G) {
        const int tb = ub * 64, b = tb / SEQ, sl0 = tb % SEQ;
        const int c = 2 * C.tid, h = c >> 7, d = c & 127;
        const bf16_t* __restrict__ src = KVb + (size_t)tb * 2048 + h * 256 + 128 + d;
        bf16_t* __restrict__ d0 = VTM + (size_t)(b * 8 + h) * 128 * SEQ + ((size_t)(sl0 >> 3) * 128 + (d >> 1)) * 8;
        for (int t8 = 0; t8 < 8; ++t8) { unsigned u[8];
#pragma unroll
            for (int ti = 0; ti < 8; ++ti) u[ti] = *(const unsigned*)(src + (size_t)(t8 * 8 + ti) * 2048);
            u32x4 lo, hi2;
            lo.x = (u[0] & 0xffffu) | (u[1] << 16); lo.y = (u[2] & 0xffffu) | (u[3] << 16); lo.z = (u[4] & 0xffffu) | (u[5] << 16); lo.w = (u[6] & 0xffffu) | (u[7] << 16);
            hi2.x = (u[0] >> 16) | (u[1] & 0xffff0000u); hi2.y = (u[2] >> 16) | (u[3] & 0xffff0000u); hi2.z = (u[4] >> 16) | (u[5] & 0xffff0000u); hi2.w = (u[6] >> 16) | (u[7] & 0xffff0000u);
            *(u32x4*)(d0 + (size_t)t8 * 128 * 8) = lo; *(u32x4*)(d0 + (size_t)t8 * 128 * 8 + 64 * 8) = hi2; }
    }
}
PH_FN ph_m4b(const Params& prm, unsigned char* lds, int l_) {
    const Ctx C = make_ctx(prm.ws, lds, l_); const int l = C.l;
    const bf16_t* __restrict__ PROJ = WSP(bf16_t, WS_BIG); const bf16_t* __restrict__ Qb = WSP(bf16_t, WS_R1); const bf16_t* __restrict__ KVb = Qb + (size_t)T * 1536;
    bf16_t* __restrict__ QH = WSP(bf16_t, WS_R2); bf16_t* __restrict__ KH = QH + (size_t)T * 8 * 192;
    const int* positions = (const int*)as_global(prm.in[1]);
    const float* qn = as_global(prm.in[19]) + (size_t)l * 192; const float* kn = as_global(prm.in[20]) + (size_t)l * 192;
    const int h = C.lane >> 3, j = C.lane & 7;
    float qw[24], kw[24], invf[4];
#pragma unroll
    for (int e = 0; e < 8; ++e) { qw[e] = qn[8 * j + e]; kw[e] = kn[8 * j + e]; qw[8 + e] = qn[64 + 8 * j + e]; kw[8 + e] = kn[64 + 8 * j + e]; }
#pragma unroll
    for (int e = 0; e < 4; ++e) { qw[16 + e] = qn[128 + 4 * j + e]; qw[20 + e] = qn[160 + 4 * j + e]; kw[16 + e] = kn[128 + 4 * j + e]; kw[20 + e] = kn[160 + 4 * j + e];
        invf[e] = 1.0f / exp2f((float)(4 * j + e) * (13.287712379549449f / 32.f)); }
    for (int row = C.gw; row < T; row += C.ngw) {
        const int b = row / SEQ, sq = row % SEQ;
        const bf16_t* q = Qb + (size_t)row * 1536 + h * 192; const bf16_t* k = KVb + (size_t)row * 2048 + h * 256; const bf16_t* pe = PROJ + (size_t)row * LDP + KPE0;
        const u32x4 qa = *(const u32x4*)(q + 8 * j), qb2 = *(const u32x4*)(q + 64 + 8 * j); const u32x2 qr1 = *(const u32x2*)(q + 128 + 4 * j), qr2 = *(const u32x2*)(q + 160 + 4 * j);
        const u32x4 ka = *(const u32x4*)(k + 8 * j), kb2 = *(const u32x4*)(k + 64 + 8 * j); const u32x2 kr1 = *(const u32x2*)(pe + 4 * j), kr2 = *(const u32x2*)(pe + 32 + 4 * j);
        const float pos = (float)positions[row];
        float cs[4], sn[4];
#pragma unroll
        for (int e = 0; e < 4; ++e) sincos_rev(pos * invf[e], cs[e], sn[e]);
        float qv[24], kv[24];
#pragma unroll
        for (int e = 0; e < 4; ++e) { qv[2 * e] = bf2f(qa[e] & 0xffffu); qv[2 * e + 1] = bf2f(qa[e] >> 16); qv[8 + 2 * e] = bf2f(qb2[e] & 0xffffu); qv[8 + 2 * e + 1] = bf2f(qb2[e] >> 16);
            kv[2 * e] = bf2f(ka[e] & 0xffffu); kv[2 * e + 1] = bf2f(ka[e] >> 16); kv[8 + 2 * e] = bf2f(kb2[e] & 0xffffu); kv[8 + 2 * e + 1] = bf2f(kb2[e] >> 16); }
#pragma unroll
        for (int e = 0; e < 2; ++e) { qv[16 + 2 * e] = bf2f(qr1[e] & 0xffffu); qv[16 + 2 * e + 1] = bf2f(qr1[e] >> 16); qv[20 + 2 * e] = bf2f(qr2[e] & 0xffffu); qv[20 + 2 * e + 1] = bf2f(qr2[e] >> 16);
            kv[16 + 2 * e] = bf2f(kr1[e] & 0xffffu); kv[16 + 2 * e + 1] = bf2f(kr1[e] >> 16); kv[20 + 2 * e] = bf2f(kr2[e] & 0xffffu); kv[20 + 2 * e + 1] = bf2f(kr2[e] >> 16); }
        float sq_ = 0.f, sk_ = 0.f;
#pragma unroll
        for (int e = 0; e < 24; ++e) { sq_ += qv[e] * qv[e]; sk_ += kv[e] * kv[e]; }
#pragma unroll
        for (int o = 1; o < 8; o <<= 1) { sq_ += __shfl_xor(sq_, o); sk_ += __shfl_xor(sk_, o); }
        const float rq = rsqrtf(sq_ * (1.f / 192.f) + 1e-6f), rk = rsqrtf(sk_ * (1.f / 192.f) + 1e-6f);
#pragma unroll
        for (int e = 0; e < 24; ++e) { qv[e] *= rq * qw[e]; kv[e] *= rk * kw[e]; }
        float q1[4], q2[4], k1[4], k2[4];
#pragma unroll
        for (int e = 0; e < 4; ++e) { q1[e] = qv[16 + e] * cs[e] - qv[20 + e] * sn[e]; q2[e] = qv[16 + e] * sn[e] + qv[20 + e] * cs[e];
            k1[e] = kv[16 + e] * cs[e] - kv[20 + e] * sn[e]; k2[e] = kv[16 + e] * sn[e] + kv[20 + e] * cs[e]; }
        bf16_t* dq = QH + ((size_t)(b * 8 + h) * SEQ + sq) * 192; bf16_t* dk = KH + ((size_t)(b * 8 + h) * SEQ + sq) * 192;
        *(u32x4*)(dq + 8 * j) = (u32x4){pk2(qv[0], qv[1]), pk2(qv[2], qv[3]), pk2(qv[4], qv[5]), pk2(qv[6], qv[7])};
        *(u32x4*)(dq + 64 + 8 * j) = (u32x4){pk2(qv[8], qv[9]), pk2(qv[10], qv[11]), pk2(qv[12], qv[13]), pk2(qv[14], qv[15])};
        *(u32x2*)(dq + 128 + 4 * j) = (u32x2){pk2(q1[0], q1[1]), pk2(q1[2], q1[3])}; *(u32x2*)(dq + 160 + 4 * j) = (u32x2){pk2(q2[0], q2[1]), pk2(q2[2], q2[3])};
        *(u32x4*)(dk + 8 * j) = (u32x4){pk2(kv[0], kv[1]), pk2(kv[2], kv[3]), pk2(kv[4], kv[5]), pk2(kv[6], kv[7])};
        *(u32x4*)(dk + 64 + 8 * j) = (u32x4){pk2(kv[8], kv[9]), pk2(kv[10], kv[11]), pk2(kv[12], kv[13]), pk2(kv[14], kv[15])};
        *(u32x2*)(dk + 128 + 4 * j) = (u32x2){pk2(k1[0], k1[1]), pk2(k1[2], k1[3])}; *(u32x2*)(dk + 160 + 4 * j) = (u32x2){pk2(k2[0], k2[1]), pk2(k2[2], k2[3])};
    }
}

PH_FN ph_m4c(const Params& prm, unsigned char* lds, int l_) {
    const Ctx C = make_ctx(prm.ws, lds, l_);
    const bf16_t* PROJ = WSP(bf16_t, WS_BIG); bf16_t* KTR = WSP(bf16_t, WS_Y) + (size_t)2 * T * 1024;
    for (int ub = C.bx; ub < T / 64; ub += C.G) {
        const int tb = ub * 64, b = tb / SEQ, sl0 = tb % SEQ;
        const int c = 2 * C.tid, h = c >> 8, e = c & 255;
        const bf16_t* __restrict__ src = PROJ + (size_t)tb * LDP + RK0 + c;
        bf16_t* __restrict__ d0 = KTR + (size_t)(b * 4 + h) * 256 * SEQ + ((size_t)(sl0 >> 3) * 256 + (e >> 1)) * 8;
        for (int t8 = 0; t8 < 8; ++t8) { unsigned u[8];
#pragma unroll
            for (int ti = 0; ti < 8; ++ti) u[ti] = *(const unsigned*)(src + (size_t)(t8 * 8 + ti) * LDP);
            u32x4 lo, hi2;
            lo.x = (u[0] & 0xffffu) | (u[1] << 16); lo.y = (u[2] & 0xffffu) | (u[3] << 16); lo.z = (u[4] & 0xffffu) | (u[5] << 16); lo.w = (u[6] & 0xffffu) | (u[7] << 16);
            hi2.x = (u[0] >> 16) | (u[1] & 0xffff0000u); hi2.y = (u[2] >> 16) | (u[3] & 0xffff0000u); hi2.z = (u[4] >> 16) | (u[5] & 0xffff0000u); hi2.w = (u[6] >> 16) | (u[7] & 0xffff0000u);
            *(u32x4*)(d0 + (size_t)t8 * 256 * 8) = lo; *(u32x4*)(d0 + (size_t)t8 * 256 * 8 + 128 * 8) = hi2; }
    }
}

PH_FN ph_m4d(const Params& prm, unsigned char* lds, int l_) {
    const Ctx C = make_ctx(prm.ws, lds, l_);
    if (C.gw < 64) {
        float* a2 = WSP(float, WS_A2S) + (size_t)C.gw * SEQ + 64 * C.lane;
        const float tot = WSP(float, WS_A2BT)[C.gw * 64 + C.lane];
        float incl = tot;
#pragma unroll
        for (int o = 1; o < 64; o <<= 1) { const float n = __shfl_up(incl, o); if (C.lane >= o) incl += n; }
        const float pre = incl - tot;
#pragma unroll
        for (int i = 0; i < 16; ++i) { f32x4 v = ((f32x4*)a2)[i]; v = v + pre; ((f32x4*)a2)[i] = v; }
    }
}
template <int DK, int DV, int NH>
__device__ __forceinline__ void state_unit(const int tid, unsigned char* lds, const bf16_t* __restrict__ Vt  , size_t vhs, const bf16_t* __restrict__ Kt  , int tc0  ,
                                           const float* __restrict__ a2c, size_t ahs, float* __restrict__ ST, size_t shs) {
    constexpr int NEB = DV / 32, NDB = DK / 32, NDBW = NEB * NDB / 8, KS = 528, NCH = DK * 32 / 512;
    const int lane = tid & 63, r32 = lane & 31, hi = lane >> 5, wid = __builtin_amdgcn_readfirstlane(tid >> 6);
    const int eb = wid % NEB, db0 = (wid / NEB) * NDBW;
    __syncthreads();
#pragma unroll
    for (int i0 = 0; i0 < NCH; i0 += 8) { u32x4 v[8];
#pragma unroll
        for (int i = 0; i < 8; ++i) { const int id = tid + 512 * (i0 + i), sg = id % DK, cc = id / DK; v[i] = *(const u32x4*)(Kt + ((size_t)(tc0 + cc) * DK + sg) * 8); }
#pragma unroll
        for (int i = 0; i < 8; ++i) { const int id = tid + 512 * (i0 + i), sg = id % DK, cc = id / DK, d = sg < DK / 2 ? 2 * sg : 2 * (sg - DK / 2) + 1; *(u32x4*)(lds + d * KS + cc * 16) = v[i]; } }
    __syncthreads();
    const unsigned char* kl = lds + (32 * db0 + r32) * KS + 16 * hi;
    const int e = 32 * eb + r32, esrc = ((e >> 1) + (e & 1) * (DV / 2)) * 8;
    for (int hh = 0; hh < NH; ++hh) {
        f32x16 acc[NDBW];
#pragma unroll
        for (int i = 0; i < NDBW; ++i)
#pragma unroll
            for (int r = 0; r < 16; ++r) acc[i][r] = 0.f;
        const float* a2h = a2c + hh * ahs; const float aend = a2h[255];
        const bf16_t* vp = Vt + hh * vhs + (size_t)(tc0 + hi) * DV * 8 + esrc;
#pragma unroll 4
        for (int ks = 0; ks < 16; ++ks) {
            const u32x4 av = *(const u32x4*)(vp + (size_t)(2 * ks) * DV * 8);
            const f32x4 w0 = *(const f32x4*)(a2h + 16 * ks + 8 * hi), w1 = *(const f32x4*)(a2h + 16 * ks + 8 * hi + 4);
            u32x4 as;
            as.x = pk2(bf2f(av.x & 0xffffu) * ex2(aend - w0[0]), bf2f(av.x >> 16) * ex2(aend - w0[1]));
            as.y = pk2(bf2f(av.y & 0xffffu) * ex2(aend - w0[2]), bf2f(av.y >> 16) * ex2(aend - w0[3]));
            as.z = pk2(bf2f(av.z & 0xffffu) * ex2(aend - w1[0]), bf2f(av.z >> 16) * ex2(aend - w1[1]));
            as.w = pk2(bf2f(av.w & 0xffffu) * ex2(aend - w1[2]), bf2f(av.w >> 16) * ex2(aend - w1[3]));
            const bf16x8 a = __builtin_bit_cast(bf16x8, as);
#pragma unroll
            for (int i = 0; i < NDBW; ++i) { const bf16x8 bq = *(const bf16x8*)(kl + (32 * i) * KS + 32 * ks); acc[i] = MFMA32(a, bq, acc[i]); }
        }
        float* st = ST + hh * shs;
#pragma unroll
        for (int i = 0; i < NDBW; ++i)
#pragma unroll
            for (int r = 0; r < 16; ++r) st[(size_t)(32 * eb + (r & 3) + 8 * (r >> 2) + 4 * hi) * DK + 32 * (db0 + i) + r32] = acc[i][r];
    }
}
PH_FN ph_state(const Params& prm, unsigned char* lds, int l_) {
    const Ctx C = make_ctx(prm.ws, lds, l_);
    const bf16_t* XT = WSP(bf16_t, WS_WA); const bf16_t* VTR = XT + (size_t)T * 1024; const bf16_t* BTS = WSP(bf16_t, WS_H) + (size_t)T * 1536;
    const bf16_t* KTR = WSP(bf16_t, WS_Y) + (size_t)2 * T * 1024;
    float* STR = WSP(float, WS_R1); float* STS = STR + (size_t)T * 1024;
    for (int u = C.bx; u < 512; u += C.G) {
        int tid = C.tid; asm volatile("" : "+v"(tid));
        if (u < 256) { const int b = u >> 6, c = (u >> 2) & 15, h = u & 3;
            state_unit<256, 256, 1>(tid, lds, VTR + (size_t)(b * 4 + h) * 256 * SEQ, 0, KTR + (size_t)(b * 4 + h) * 256 * SEQ, c * 32, WSP(float, WS_A2R) + h * SEQ + c * 256, 0,
                                    STR + (size_t)((b * 16 + c) * 4 + h) * 65536, 0);
        } else { const int v = u - 256, b = v >> 6, c = (v >> 2) & 15, g = (v >> 1) & 1, h0 = g * 8 + (v & 1) * 4;
            state_unit<128, 64, 4>(tid, lds, XT + (size_t)(b * 16 + h0) * 64 * SEQ, (size_t)64 * SEQ, BTS + (size_t)(b * 2 + g) * 128 * SEQ, c * 32,
                                   WSP(float, WS_A2S) + (size_t)(b * 16 + h0) * SEQ + c * 256, (size_t)SEQ, STS + (size_t)((b * 16 + c) * 16 + h0) * 8192, (size_t)8192);
        }
    }
}
PH_FN ph_scan(const Params& prm, unsigned char* lds, int l_) {
    const Ctx C = make_ctx(prm.ws, lds, l_);
    float* STR = WSP(float, WS_R1); float* STS = STR + (size_t)T * 1024;
    const float* A2S = WSP(float, WS_A2S); const float* A2R = WSP(float, WS_A2R);
    const int gt = C.bx * NTHREADS + C.tid, ngt = C.G * NTHREADS;
    for (int i = gt; i < 4 * 4 * 16384; i += ngt) {
        const int b = i >> 16, h = (i >> 14) & 3, el = i & 16383;
        const float dec = ex2(A2R[h * SEQ + 256]);
        f32x4 loc[16];
#pragma unroll
        for (int c = 0; c < 16; ++c) loc[c] = *((const f32x4*)(STR + (size_t)((b * 16 + c) * 4 + h) * 65536) + el);
        f32x4 run = {0.f, 0.f, 0.f, 0.f};
#pragma unroll
        for (int c = 0; c < 16; ++c) { *((f32x4*)(STR + (size_t)((b * 16 + c) * 4 + h) * 65536) + el) = run; run = run * dec + loc[c]; }
    }
    for (int i = gt; i < 4 * 16 * 2048; i += ngt) {
        const int b = i >> 15, h = (i >> 11) & 15, el = i & 2047;
        const float* a2 = A2S + (size_t)(b * 16 + h) * SEQ;
        f32x4 loc[16]; float dec[16];
#pragma unroll
        for (int c = 0; c < 16; ++c) { loc[c] = *((const f32x4*)(STS + (size_t)((b * 16 + c) * 16 + h) * 8192) + el); dec[c] = ex2(a2[c * 256 + 255] - (c ? a2[c * 256 - 1] : 0.f)); }
        f32x4 run = {0.f, 0.f, 0.f, 0.f};
#pragma unroll
        for (int c = 0; c < 16; ++c) { *((f32x4*)(STS + (size_t)((b * 16 + c) * 16 + h) * 8192) + el) = run; run = run * dec[c] + loc[c]; }
    }
}
PH_FN ph_m5(const Params& prm, unsigned char* lds, int l_, int* s_unit) {
    const Ctx C = make_ctx(prm.ws, lds, l_);
    unsigned* qctr = WSP(unsigned, WS_CTL) + 64 * (C.l + 1);
    bf16_t* Yb = WSP(bf16_t, WS_Y);
    for (;;) {
        __syncthreads();
        if (C.tid == 0) *s_unit = (int)atomicAdd(qctr, 1u);
        __syncthreads();
        int idx = *s_unit; idx = __builtin_amdgcn_readfirstlane(idx);
        if (idx >= 2048) break;
        int tid = C.tid; asm volatile("" : "+v"(tid));
        if (idx < 512) {
            const int qb = 15 - (idx >> 5), rem = idx & 31;
            const int b = rem >> 3, h = rem & 7; const size_t bh = (size_t)(b * 8 + h);
            const bf16_t* QH = WSP(bf16_t, WS_R2); const bf16_t* KH = QH + (size_t)T * 8 * 192; const bf16_t* VTM = KH + (size_t)T * 8 * 192;
            attn_unit<192, 128, 0, 128>(tid, lds, QH + bh * SEQ * 192, 192, KH + bh * SEQ * 192, 192, VTM + bh * 128 * SEQ, nullptr, 0.07216878364870322f * LOG2E,
                                   Yb + (size_t)T * 1024 + (size_t)b * SEQ * 1024 + h * 128, 1024, qb, nullptr, 0);
        } else if (idx < 1024) {
            const int qb = (idx - 512) >> 5, r2 = idx & 31, b = r2 >> 3, h = (r2 & 7) >> 1, half = r2 & 1;
            const bf16_t* PROJ = WSP(bf16_t, WS_BIG); const bf16_t* VTR = WSP(bf16_t, WS_WA) + (size_t)T * 1024;
            attn_unit<256, 128, 1, 256>(tid, lds, PROJ + (size_t)b * SEQ * LDP + RQ0 + h * 256, LDP, PROJ + (size_t)b * SEQ * LDP + RK0 + h * 256, LDP,
                                   VTR + (size_t)(b * 4 + h) * 256 * SEQ, WSP(float, WS_A2R) + h * SEQ, 0.f,
                                   Yb + (size_t)2 * T * 1024 + (size_t)b * SEQ * 1024 + h * 256 + half * 128, 1024, qb,
                                   WSP(float, WS_R1) + ((size_t)((b * 16 + qb) * 4 + h) * 256 + half * 128) * 256, half * 128);
        } else {
            const int qb = (idx - 1024) >> 6, r3 = idx & 63, b = r3 >> 4, h = r3 & 15, gq = h >> 3;
            const bf16_t* BC = WSP(bf16_t, WS_H) + (size_t)T * 1024; const bf16_t* XT = WSP(bf16_t, WS_WA);
            attn_unit<128, 64, 1, 64>(tid, lds, BC + (size_t)b * SEQ * 512 + 256 + gq * 128, 512, BC + (size_t)b * SEQ * 512 + gq * 128, 512,
                                  XT + (size_t)(b * 16 + h) * 64 * SEQ, WSP(float, WS_A2S) + (size_t)(b * 16 + h) * SEQ, 0.f,
                                  Yb + (size_t)b * SEQ * 1024 + h * 64, 1024, qb,
                                  WSP(float, WS_R1) + (size_t)T * 1024 + (size_t)((b * 16 + qb) * 16 + h) * 64 * 128, 0);
        }
    }
}
PH_FN ph_m6(const Params& prm, unsigned char* lds, int l_) {
    const Ctx C = make_ctx(prm.ws, lds, l_); const int l = C.l;
    const bf16_t* PROJ = WSP(bf16_t, WS_BIG); const bf16_t* XS = WSP(bf16_t, WS_H); bf16_t* Yb = WSP(bf16_t, WS_Y);
    const float* dsk = as_global(prm.in[13]) + (size_t)l * 16; const float* ssn = as_global(prm.in[14]) + (size_t)l * 1024; const float* rtn = as_global(prm.in[21]) + (size_t)l * 1024;
    f32x4 sw[2][2]; f32x4 rw[4]; float ds[2];
#pragma unroll
    for (int gq = 0; gq < 2; ++gq) { const int c0 = gq * 512 + 8 * C.lane; ds[gq] = dsk[c0 >> 6]; sw[gq][0] = *(const f32x4*)(ssn + c0); sw[gq][1] = *(const f32x4*)(ssn + c0 + 4); }
#pragma unroll
    for (int h = 0; h < 4; ++h) rw[h] = *(const f32x4*)(rtn + h * 256 + 4 * C.lane);
    for (int row = C.gw; row < T; row += C.ngw) {
        const bf16_t* pr = PROJ + (size_t)row * LDP;
        bf16_t* y0 = Yb + (size_t)row * 1024; bf16_t* y2 = Yb + (size_t)2 * T * 1024 + (size_t)row * 1024;
        u32x4 yu[2], xu[2], zu[2]; u32x2 ru[4], gu[4];
#pragma unroll
        for (int gq = 0; gq < 2; ++gq) { const int c0 = gq * 512 + 8 * C.lane; yu[gq] = *(const u32x4*)(y0 + c0); xu[gq] = *(const u32x4*)(XS + (size_t)row * 1024 + c0); zu[gq] = *(const u32x4*)(pr + Z0 + c0); }
#pragma unroll
        for (int h = 0; h < 4; ++h) { const int c0 = h * 256 + 4 * C.lane; ru[h] = *(const u32x2*)(y2 + c0); gu[h] = *(const u32x2*)(pr + RG0 + c0); }
        float v[2][8], ss[6];
#pragma unroll
        for (int gq = 0; gq < 2; ++gq) { float s = 0.f;
#pragma unroll
            for (int j = 0; j < 4; ++j) { const unsigned a = yu[gq][j], xx = xu[gq][j], zz = zu[gq][j];
                v[gq][2 * j] = (bf2f(a & 0xffffu) + ds[gq] * bf2f(xx & 0xffffu)) * siluf_(bf2f(zz & 0xffffu));
                v[gq][2 * j + 1] = (bf2f(a >> 16) + ds[gq] * bf2f(xx >> 16)) * siluf_(bf2f(zz >> 16)); }
#pragma unroll
            for (int j = 0; j < 8; ++j) s += v[gq][j] * v[gq][j];
            ss[gq] = s; }
        float rv[4][4];
#pragma unroll
        for (int h = 0; h < 4; ++h) { rv[h][0] = bf2f(ru[h].x & 0xffffu); rv[h][1] = bf2f(ru[h].x >> 16); rv[h][2] = bf2f(ru[h].y & 0xffffu); rv[h][3] = bf2f(ru[h].y >> 16);
            ss[2 + h] = rv[h][0] * rv[h][0] + rv[h][1] * rv[h][1] + rv[h][2] * rv[h][2] + rv[h][3] * rv[h][3]; }
#pragma unroll
        for (int o = 1; o < 64; o <<= 1) {
#pragma unroll
            for (int q = 0; q < 6; ++q) ss[q] += __shfl_xor(ss[q], o); }
#pragma unroll
        for (int gq = 0; gq < 2; ++gq) { const float r = rsqrtf(ss[gq] * (1.f / 512.f) + 1e-6f); const f32x4 w0 = sw[gq][0], w1 = sw[gq][1];
            u32x4 o; o.x = pk2(v[gq][0] * r * w0[0], v[gq][1] * r * w0[1]); o.y = pk2(v[gq][2] * r * w0[2], v[gq][3] * r * w0[3]); o.z = pk2(v[gq][4] * r * w1[0], v[gq][5] * r * w1[1]); o.w = pk2(v[gq][6] * r * w1[2], v[gq][7] * r * w1[3]);
            *(u32x4*)(y0 + gq * 512 + 8 * C.lane) = o; }
#pragma unroll
        for (int h = 0; h < 4; ++h) { const float r = rsqrtf(ss[2 + h] * (1.f / 256.f) + 1e-6f); const f32x4 w = rw[h];
            const float g0 = bf2f(gu[h].x & 0xffffu), g1 = bf2f(gu[h].x >> 16), g2 = bf2f(gu[h].y & 0xffffu), g3 = bf2f(gu[h].y >> 16);
            u32x2 o; o.x = pk2(rv[h][0] * r * w[0] * siluf_(g0), rv[h][1] * r * w[1] * siluf_(g1)); o.y = pk2(rv[h][2] * r * w[2] * siluf_(g2), rv[h][3] * r * w[3] * siluf_(g3));
            *(u32x2*)(y2 + h * 256 + 4 * C.lane) = o; }
    }
}
PH_FN ph_m7(const Params& prm, unsigned char* lds, int l_) {
    const Ctx C = make_ctx(prm.ws, lds, l_);
    pg8::Gemm g{WSP(bf16_t, WS_Y), WSP(bf16_t, WS_WS + WBR_OFF), T, DM, 1024, 1024, 0, 1}; pg8::MergeOrder S; S.so.init(T, DM, C.G, C.bx);
    pg8::EpiMerge E{WSP(bf16_t, WS_BIG + GATE_OFF), WSP(bf16_t, WS_H)};
    pg8::gemm_phase(C.tid, (LAS unsigned char*)lds, g, S, E);
}
PH_FN ph_m8(const Params& prm, unsigned char* lds, int l_) {
    const Ctx C = make_ctx(prm.ws, lds, l_);
    pg8::Gemm g{WSP(bf16_t, WS_H), WSP(bf16_t, WS_WS + WOUT_OFF), T, DM, DM, DM, 1, 1}; pg8::StaticOrder S; S.init(T, DM, C.G, C.bx);
    pg8::EpiResid E{as_global(prm.out), as_global(prm.out), 1.0f};
    pg8::gemm_phase(C.tid, (LAS unsigned char*)lds, g, S, E);
}

#ifndef PHMASK
#define PHMASK 0xffffffu
#endif
#define GSYNC() xcd_barrier(xbar)
#define PH(k, call) do { if constexpr ((PHMASK >> (k)) & 1u) { call; } GSYNC(); } while (0)
__global__ void __launch_bounds__(NTHREADS, 2) fwd_kernel(Params prm) {
    extern __shared__ __attribute__((aligned(16))) unsigned char lds[];
    __shared__ int s_unit;
    __shared__ unsigned s_bar[2];
    cg::grid_group grid = cg::this_grid();
    if (threadIdx.x < 2) s_bar[threadIdx.x] = 0u;
    __syncthreads();
    if (blockIdx.x == 0) { unsigned* ctl0 = (unsigned*)(as_global(prm.ws) + WS_CTL); for (int i = threadIdx.x; i < 8192; i += NTHREADS) ctl0[i] = 0u; }
    XcdBarrier xbar; xbar.bar = nullptr; xbar.x = 0u; xbar.st = nullptr;
    for (int l = 0; l < DEPTH; ++l) {
        for (int ffn = 0; ffn < 2; ++ffn) {
            if (ffn == 1) {
                PH(0, ph_m0(prm, lds, l));
                PH(1, ph_m1(prm, lds, l));
                if constexpr ((PHMASK >> 2) & 1u) { ph_m2a(prm, lds, l); ph_m2b(prm, lds, l); ph_m2c(prm, lds, l); }
                GSYNC();
                if constexpr ((PHMASK >> 3) & 1u) { ph_m3a(prm, lds, l); ph_m3b(prm, lds, l); }
                GSYNC();
                if constexpr ((PHMASK >> 4) & 1u) { ph_m4a(prm, lds, l); ph_m4b(prm, lds, l); ph_m4c(prm, lds, l); ph_m4d(prm, lds, l); }
                GSYNC();
                PH(12, ph_state(prm, lds, l));
                PH(13, ph_scan(prm, lds, l));
                PH(5, ph_m5(prm, lds, l, &s_unit));
                PH(6, ph_m6(prm, lds, l));
                PH(7, ph_m7(prm, lds, l));
                PH(8, ph_m8(prm, lds, l));
            }
            if constexpr ((PHMASK >> 9) & 1u) { ph_ffn_prep(prm, lds, l, ffn); }
            if (l == 0 && ffn == 0) { grid.sync();
                xbar = xcd_barrier_post((unsigned*)(as_global(prm.ws) + WS_CTL) + 1024, (volatile LAS unsigned*)s_bar); }
            else GSYNC();
            PH(10, ph_ffn_gu(prm, lds, l));
            PH(11, ph_ffn_dn(prm, lds, l, ffn));
        }
    }
}

extern "C" void kernel_launch(void* const* d_in, const int* in_sizes, int n_in, void* d_out, int out_size, void* d_ws, size_t ws_size, hipStream_t stream) {
    static int grid = 0;
    if (grid == 0) {
        if (n_in != 30 || out_size != T * DM || ws_size < WS_END) { fprintf(stderr, "kernel_launch: unexpected shapes / workspace (n_in %d out %d ws %zu need %zu)\n", n_in, out_size, ws_size, (size_t)WS_END); grid = -1; return; }
        int dev = 0, cus = 0, per_cu = 0;
        hipGetDevice(&dev);
        hipDeviceGetAttribute(&cus, hipDeviceAttributeMultiprocessorCount, dev);
        hipFuncSetAttribute((const void*)fwd_kernel, hipFuncAttributeMaxDynamicSharedMemorySize, LDS_BYTES);
        hipOccupancyMaxActiveBlocksPerMultiprocessor(&per_cu, (const void*)fwd_kernel, NTHREADS, LDS_BYTES);
        if (per_cu < 1) per_cu = 1;
        grid = cus * per_cu;
        (void)hipGetLastError();
    }
    if (grid < 0) return;
    Params p{};
    for (int i = 0; i < 30; ++i) p.in[i] = (const float*)d_in[i];
    p.out = (float*)d_out; p.ws = (unsigned char*)d_ws;
    void* args[] = {&p};
    hipError_t e = hipLaunchCooperativeKernel((const void*)fwd_kernel, dim3(grid), dim3(NTHREADS), args, LDS_BYTES, stream);
    if (e != hipSuccess) fprintf(stderr, "cooperative launch failed: %s (grid %d)\n", hipGetErrorString(e), grid);
}
```

```cpp
#include <hip/hip_runtime.h>
#include <hip/hip_cooperative_groups.h>
#include <cstdio>
#include <cstdint>
namespace cg = cooperative_groups;

#define LAS __attribute__((address_space(3)))
typedef unsigned short bf16_t;
typedef short bf16x8 __attribute__((ext_vector_type(8)));
typedef float f32x4 __attribute__((ext_vector_type(4)));
typedef float f32x2 __attribute__((ext_vector_type(2)));
typedef float f32x16 __attribute__((ext_vector_type(16)));
typedef unsigned u32x4 __attribute__((ext_vector_type(4)));
typedef unsigned u32x2 __attribute__((ext_vector_type(2)));
typedef __bf16 bf16x2_t __attribute__((ext_vector_type(2)));

constexpr int T = 16384, SEQ = 4096, NBATCH = 4, DM = 2048, DFF = 5632, DIN = 14160, NPROJ = 14336  , LDP = 8192  , DEPTH = 2;
constexpr int Z0 = 0, XBC0 = 1024, QL0 = 2560, KVL0 = 3328, KPE0 = 3840, DT0 = 3904, RQ0 = 4096, RK0 = 5120, RV0 = 6144, RG0 = 7168, GT0 = 8192;
constexpr float LOG2E = 1.4426950408889634f;

constexpr size_t MB = 1000000;
constexpr size_t al(size_t x) { return (x + 4095) / 4096 * 4096; }
constexpr size_t WS_CTL = 0;
constexpr size_t WS_A2S = 65536;
constexpr size_t WS_A2R = WS_A2S + (size_t)4 * 16 * 4096 * 4;
constexpr size_t WS_A2BT = WS_A2R + 4 * 4096 * 4;
constexpr size_t WS_WS = al(WS_A2BT + 4 * 16 * 64 * 4);
constexpr size_t WQB_OFF = 0, WKVB_OFF = (size_t)1536 * 768 * 2, WBR_OFF = WKVB_OFF + (size_t)2048 * 512 * 2, WOUT_OFF = WBR_OFF + (size_t)3 * 2048 * 1024 * 2;
constexpr size_t WS_WA = al(WS_WS + WOUT_OFF + (size_t)2048 * 2048 * 2);
constexpr size_t WA_BYTES = (size_t)T * 2048 * 2;
constexpr size_t WS_H = al(WS_WA + WA_BYTES);
constexpr size_t WS_BIG = al(WS_H + (size_t)T * 2048 * 2);
constexpr size_t BIG_BYTES = (size_t)T * NPROJ * 2;
constexpr size_t GATE_OFF = (size_t)T * LDP * 2;
constexpr size_t FFW_GU = 0, FFW_DN = (size_t)11264 * 2048 * 2, FF_HID = FFW_DN + (size_t)2048 * 5632 * 2;
constexpr size_t WS_R1 = al(WS_BIG + BIG_BYTES);
constexpr size_t R1_BYTES = (size_t)T * (1536 + 2048) * 2;
constexpr size_t WS_R2 = al(WS_R1 + R1_BYTES);
constexpr size_t R2_BYTES = (size_t)T * 2048 * 4;
constexpr size_t WS_Y = al(WS_R2 + R2_BYTES);
constexpr size_t WS_END = WS_Y + (size_t)3 * T * 1024 * 2;
static_assert(FF_HID + (size_t)T * DFF * 2 <= BIG_BYTES, "ffn overlay");
static_assert((size_t)T * 8 * (192 + 192 + 128) * 2 <= R2_BYTES, "R2");

struct Params {
    const float* in[30];
    float* out;
    unsigned char* ws;
};

template <class T> __device__ __forceinline__ T* as_global(T* p) { return (T*)(__attribute__((address_space(1))) T*)p; }
__device__ __forceinline__ float bf2f(unsigned v) { return __uint_as_float(v << 16); }
__device__ __forceinline__ unsigned pk2(float lo, float hi) { f32x2 v = {lo, hi}; bf16x2_t b = __builtin_convertvector(v, bf16x2_t); return __builtin_bit_cast(unsigned, b); }
__device__ __forceinline__ float ex2(float x) { return __builtin_amdgcn_exp2f(x); }
__device__ __forceinline__ float rcpf_(float x) { return __builtin_amdgcn_rcpf(x); }
__device__ __forceinline__ float sigmoidf_(float x) { return rcpf_(1.f + ex2(-x * LOG2E)); }
__device__ __forceinline__ float siluf_(float x) { return x * sigmoidf_(x); }
__device__ __forceinline__ float wave_sum(float v) {
#pragma unroll
    for (int o = 1; o < 64; o <<= 1) v += __shfl_xor(v, o);
    return v;
}
__device__ __forceinline__ void sincos_rev(float ang, float& c, float& s) {
    double rev = (double)ang * 0.15915494309189535; rev -= floor(rev);
    float fr = (float)rev; s = __builtin_amdgcn_sinf(fr); c = __builtin_amdgcn_cosf(fr);
}

namespace pg8 {
constexpr int BM = 256, BK = 64, HALF = 128, HTB = HALF * BK * 2, STAGE_BYTES = 8 * HTB, NXCD = 8, WGM = 8;
__host__ __device__ __forceinline__ int lds_byte(int r, int c) { const int st = (r >> 4) * 2 + (c >> 5), rr = r & 15, cc = c & 31, ob = rr * 64 + cc * 2; return st * 1024 + (ob ^ (((ob >> 9) & 1) << 5)); }
__host__ __device__ __forceinline__ void stage_rc(int b, int& R, int& C) { const int st = b / 1024, sb = b % 1024, swz = sb ^ (((sb >> 9) & 1) << 5); R = (st >> 1) * 16 + swz / 64; C = (st & 1) * 32 + (swz % 64) / 2; }
__host__ __device__ __forceinline__ int perm32(int rho) { const int n = rho >> 4, i = rho & 15; return 8 * (i >> 2) + 4 * n + (i & 3); }

struct Unit { int pm, pn; };
struct Gemm { const bf16_t* A; const bf16_t* Bt; int M, N, K, lda; int blockedA, blockedB; };

struct StaticOrder {
    int nM, nN, nwg, G, c;
    __device__ void init(int M, int N, int G_, int c_) { nM = M / BM; nN = N / BM; nwg = nM * nN; G = G_; c = c_; }
    __device__ bool next(int i, Unit& u) const {
        const long L = (long)i * G + c; if (L >= nwg) return false;
        int wgid = (int)L; { const int q = nwg / NXCD, r = nwg % NXCD, xcd = wgid % NXCD, off = wgid / NXCD; wgid = (xcd < r ? xcd * (q + 1) : r * (q + 1) + (xcd - r) * q) + off; }
        const int nig = WGM * nN, gid = wgid / nig, fm = gid * WGM, gsz = (nM - fm) < WGM ? (nM - fm) : WGM;
        u.pm = fm + ((wgid % nig) % gsz); u.pn = (wgid % nig) / gsz; return true;
    }
};
struct MergeOrder {
    StaticOrder so;
    __device__ bool next(int i, Unit& u) const { Unit b; if (!so.next(i / 3, b)) return false; const int br = i % 3; u.pm = br * 64 + b.pm; u.pn = br * 8 + b.pn; return true; }
};

struct EpiBf16 {
    static constexpr bool PERM = true;
    bf16_t* O; int ldc; const float* gbias; int gate0; bf16_t* G;
    __device__ __forceinline__ void operator()(const f32x4 (&acc)[2][2][4][2], const Unit& u, int wr, int wc, int fr, int fq) const {
        const int row0 = u.pm * BM + wr * 64 + fr, col0 = u.pn * BM + wc * 32 + 8 * fq;
        const bool gate = gbias != nullptr && u.pn * BM >= gate0;
        f32x4 gb[2][2];
        if (gate) {
#pragma unroll
            for (int bj = 0; bj < 2; ++bj)
#pragma unroll
                for (int n = 0; n < 2; ++n) gb[bj][n] = *(const f32x4*)(gbias + (col0 - gate0) + bj * HALF + 4 * n); }
#pragma unroll
        for (int ai = 0; ai < 2; ++ai)
#pragma unroll
            for (int m = 0; m < 4; ++m) {
                bf16_t* rowp = gate ? G + ((size_t)((((u.pn - gate0 / BM) >> 3) * 64 + u.pm) * 8 + ((u.pn - gate0 / BM) & 7)) * 256 + (wr * 64 + fr + ai * HALF + m * 16)) * 256 + wc * 32 + 8 * fq
                                    : O + (size_t)(row0 + ai * HALF + m * 16) * ldc + col0;
#pragma unroll
                for (int bj = 0; bj < 2; ++bj) { f32x4 v0 = acc[ai][bj][m][0], v1 = acc[ai][bj][m][1];
                    if (gate) {
#pragma unroll
                        for (int j = 0; j < 4; ++j) { v0[j] = sigmoidf_(v0[j] + gb[bj][0][j]); v1[j] = sigmoidf_(v1[j] + gb[bj][1][j]); } }
                    u32x4 w; w.x = pk2(v0[0], v0[1]); w.y = pk2(v0[2], v0[3]); w.z = pk2(v1[0], v1[1]); w.w = pk2(v1[2], v1[3]);
                    *(u32x4*)(rowp + bj * HALF) = w; } }
    }
};
struct EpiSwiGLU {
    static constexpr bool PERM = true;
    bf16_t* O; int ldc;
    __device__ __forceinline__ void operator()(const f32x4 (&acc)[2][2][4][2], const Unit& u, int wr, int wc, int fr, int fq) const {
        const int row0 = u.pm * BM + wr * 64 + fr, col0 = u.pn * HALF + wc * 32 + 8 * fq;
#pragma unroll
        for (int ai = 0; ai < 2; ++ai)
#pragma unroll
            for (int m = 0; m < 4; ++m) { const int r = row0 + ai * HALF + m * 16;
                bf16_t* rowp = O + ((size_t)((r >> 8) * (ldc >> 6) + (col0 >> 6)) * 256 + (r & 255)) * 64 + (col0 & 63);
                float h[8];
#pragma unroll
                for (int n = 0; n < 2; ++n)
#pragma unroll
                    for (int j = 0; j < 4; ++j) h[n * 4 + j] = siluf_(acc[ai][0][m][n][j]) * acc[ai][1][m][n][j];
                u32x4 w; w.x = pk2(h[0], h[1]); w.y = pk2(h[2], h[3]); w.z = pk2(h[4], h[5]); w.w = pk2(h[6], h[7]);
                *(u32x4*)rowp = w; }
    }
};
struct EpiResid {
    static constexpr bool PERM = false;
    const float* base; float* out; float scale;
    __device__ __forceinline__ void operator()(const f32x4 (&acc)[2][2][4][2], const Unit& u, int wr, int wc, int fr, int fq) const {
        const int row0 = u.pm * BM + wr * 64 + fr, col0 = u.pn * BM + wc * 32 + 4 * fq;
#pragma unroll
        for (int ai = 0; ai < 2; ++ai) {
            f32x4 bv[4][2][2];
#pragma unroll
            for (int m = 0; m < 4; ++m) { const size_t off = (size_t)(row0 + ai * HALF + m * 16) * DM + col0;
#pragma unroll
                for (int bj = 0; bj < 2; ++bj)
#pragma unroll
                    for (int n = 0; n < 2; ++n) bv[m][bj][n] = *(const f32x4*)(base + off + bj * HALF + n * 16); }
#pragma unroll
            for (int m = 0; m < 4; ++m) { const size_t off = (size_t)(row0 + ai * HALF + m * 16) * DM + col0;
#pragma unroll
                for (int bj = 0; bj < 2; ++bj)
#pragma unroll
                    for (int n = 0; n < 2; ++n) *(f32x4*)(out + off + bj * HALF + n * 16) = bv[m][bj][n] + acc[ai][bj][m][n] * scale; }
            asm volatile("" ::: "memory");
        }
    }
};
struct EpiMerge {
    static constexpr bool PERM = true;
    const bf16_t* proj; bf16_t* Mg;
    __device__ __forceinline__ void operator()(const f32x4 (&acc)[2][2][4][2], const Unit& u, int wr, int wc, int fr, int fq) const {
        const int br = u.pn >> 3, pn = u.pn & 7, pm = u.pm & 63;
        const int row0 = pm * BM + wr * 64 + fr, col0 = pn * BM + wc * 32 + 8 * fq;
#pragma unroll
        for (int ai = 0; ai < 2; ++ai) {
            u32x4 gw[4][2], pw[4][2];
#pragma unroll
            for (int m = 0; m < 4; ++m) { const int row = row0 + ai * HALF + m * 16;
#pragma unroll
                for (int bj = 0; bj < 2; ++bj) { const int col = col0 + bj * HALF;
                    gw[m][bj] = *(const u32x4*)(proj + ((size_t)((br * 64 + pm) * 8 + pn) * 256 + (row & 255)) * 256 + (col & 255));
                    pw[m][bj] = *(const u32x4*)(Mg + ((size_t)((row >> 8) * (DM / 64) + (col >> 6)) * 256 + (row & 255)) * 64 + (col & 63)); } }
#pragma unroll
            for (int m = 0; m < 4; ++m) { const int row = row0 + ai * HALF + m * 16;
#pragma unroll
                for (int bj = 0; bj < 2; ++bj) { const int col = col0 + bj * HALF;
                    const f32x4 v0 = acc[ai][bj][m][0], v1 = acc[ai][bj][m][1]; const u32x4 g = gw[m][bj]; const u32x4 p = br != 0 ? pw[m][bj] : (u32x4){0u, 0u, 0u, 0u};
                    u32x4 w;
                    w.x = pk2(bf2f(p.x & 0xffffu) + bf2f(g.x & 0xffffu) * v0[0], bf2f(p.x >> 16) + bf2f(g.x >> 16) * v0[1]);
                    w.y = pk2(bf2f(p.y & 0xffffu) + bf2f(g.y & 0xffffu) * v0[2], bf2f(p.y >> 16) + bf2f(g.y >> 16) * v0[3]);
                    w.z = pk2(bf2f(p.z & 0xffffu) + bf2f(g.z & 0xffffu) * v1[0], bf2f(p.z >> 16) + bf2f(g.z >> 16) * v1[1]);
                    w.w = pk2(bf2f(p.w & 0xffffu) + bf2f(g.w & 0xffffu) * v1[2], bf2f(p.w >> 16) + bf2f(g.w >> 16) * v1[3]);
                    *(u32x4*)(Mg + ((size_t)((row >> 8) * (DM / 64) + (col >> 6)) * 256 + (row & 255)) * 64 + (col & 63)) = w; } }
            asm volatile("" ::: "memory");
        }
    }
};

template <class Epi, class Sched>
__device__ __forceinline__ void gemm_phase(const int tid, LAS unsigned char* lds, const Gemm g, const Sched& S, const Epi& E) {
    const int wid = __builtin_amdgcn_readfirstlane(tid >> 6), lane = tid & 63, wr = wid >> 2, wc = wid & 3, fr = lane & 15, fq = lane >> 4;
    const int K = g.K, nt = K / BK, lda = g.blockedA ? BK : g.lda, ldb = g.blockedB ? BK : K;
    unsigned voffA[2], voffB[2];
#pragma unroll
    for (int i = 0; i < 2; ++i) { int R, C; stage_rc(tid * 16 + i * 8192, R, C); const int Rb = Epi::PERM ? ((R & ~31) + perm32(R & 31)) : R;
        voffA[i] = (unsigned)(R * lda + C) * 2u; voffB[i] = (unsigned)(Rb * ldb + C) * 2u; }
    const size_t kstepA = g.blockedA ? (size_t)BM * BK * 2 : (size_t)(BK * 2), kstepB = g.blockedB ? (size_t)BM * BK * 2 : (size_t)(BK * 2);
    const size_t hstepA = (size_t)HALF * lda * 2, hstepB = (size_t)HALF * ldb * 2;
    const size_t tstepA = g.blockedA ? (size_t)nt * BM * BK * 2 : 2 * hstepA, tstepB = g.blockedB ? (size_t)nt * BM * BK * 2 : 2 * hstepB;
    const unsigned ldsw = (unsigned)wid * 1024u;
    const int aoff = lds_byte(wr * 64 + fr, fq * 8), boff = lds_byte(wc * 32 + fr, fq * 8);
#define PG8_SA(b, h) (((b) * 2 + (h)) * HTB)
#define PG8_SB(b, h) ((4 + (b) * 2 + (h)) * HTB)
#define PG8_STAGE(bufoff, gbase, voff) do { _Pragma("unroll") for (int _i = 0; _i < 2; ++_i) \
        __builtin_amdgcn_global_load_lds((const unsigned*)((const char*)(gbase) + (voff)[_i]), (LAS unsigned*)(lds + (bufoff) + ldsw + _i * 8192), 16, 0, 0); } while (0)
#define PG8_LDA(dst, b, h) do { _Pragma("unroll") for (int m = 0; m < 4; ++m) _Pragma("unroll") for (int k = 0; k < 2; ++k) dst[m][k] = *(const LAS bf16x8*)(lds + PG8_SA(b, h) + aoff + m * 2048 + k * 1024); } while (0)
#define PG8_LDB(dst, b, h) do { _Pragma("unroll") for (int n = 0; n < 2; ++n) _Pragma("unroll") for (int k = 0; k < 2; ++k) dst[n][k] = *(const LAS bf16x8*)(lds + PG8_SB(b, h) + boff + n * 2048 + k * 1024); } while (0)
#define PG8_MMA(ai, bj, At, Bt) do { __builtin_amdgcn_s_setprio(1); _Pragma("unroll") for (int m = 0; m < 4; ++m) _Pragma("unroll") for (int n = 0; n < 2; ++n) _Pragma("unroll") for (int k = 0; k < 2; ++k) \
        acc[ai][bj][m][n] = __builtin_amdgcn_mfma_f32_16x16x32_bf16(Bt[n][k], At[m][k], acc[ai][bj][m][n], 0, 0, 0); __builtin_amdgcn_s_setprio(0); } while (0)
#define PG8_WAIT_V(n) asm volatile("s_waitcnt vmcnt(" #n ")" ::: "memory")
#define PG8_WAIT_L(n) asm volatile("s_waitcnt lgkmcnt(" #n ")" ::: "memory")
#define PG8_BAR __builtin_amdgcn_s_barrier()
#define PG8_SCHED __builtin_amdgcn_sched_barrier(0)
    Unit cur, nxt; int ui = 0;
    if (!S.next(0, cur)) return;
    f32x4 acc[2][2][4][2];
#pragma unroll
    for (int a = 0; a < 2; ++a)
#pragma unroll
        for (int b = 0; b < 2; ++b)
#pragma unroll
            for (int m = 0; m < 4; ++m)
#pragma unroll
                for (int n = 0; n < 2; ++n) acc[a][b][m][n] = (f32x4){0.f, 0.f, 0.f, 0.f};
    bf16x8 At[4][2], B0[2][2], B1[2][2];
    const char* cA = (const char*)g.A + (size_t)cur.pm * tstepA; const char* cB = (const char*)g.Bt + (size_t)cur.pn * tstepB;
    PG8_STAGE(PG8_SB(0, 0), cB, voffB); PG8_STAGE(PG8_SB(0, 1), cB + hstepB, voffB); PG8_STAGE(PG8_SA(0, 0), cA, voffA); PG8_STAGE(PG8_SA(0, 1), cA + hstepA, voffA);
    if (wr == 1) PG8_BAR;
    PG8_WAIT_V(2); PG8_BAR;
    PG8_STAGE(PG8_SB(1, 0), cB + kstepB, voffB); PG8_STAGE(PG8_SA(1, 0), cA + kstepA, voffA); PG8_STAGE(PG8_SB(1, 1), cB + hstepB + kstepB, voffB);
    PG8_WAIT_V(6); PG8_BAR;
    for (;;) {
        const bool has_next = S.next(ui + 1, nxt);
        const char* nA = has_next ? (const char*)g.A + (size_t)nxt.pm * tstepA : cA; const char* nB = has_next ? (const char*)g.Bt + (size_t)nxt.pn * tstepB : cB;
        for (int t = 0; t < nt; t += 2) {
            const bool last = (t == nt - 2);
            const char* a1 = cA + (size_t)(t + 1) * kstepA;
            const char* a2 = last ? nA : cA + (size_t)(t + 2) * kstepA; const char* b2 = last ? nB : cB + (size_t)(t + 2) * kstepB;
            const char* a3 = a2 + kstepA; const char* b3 = b2 + kstepB;
            PG8_LDB(B0, 0, 0); PG8_LDB(B1, 0, 1); PG8_SCHED; PG8_LDA(At, 0, 0); PG8_STAGE(PG8_SA(1, 1), a1 + hstepA, voffA);
            PG8_WAIT_V(8); PG8_WAIT_L(0); PG8_BAR; PG8_MMA(0, 0, At, B0); PG8_MMA(0, 1, At, B1); PG8_BAR; PG8_SCHED;
            PG8_LDA(At, 0, 1); PG8_STAGE(PG8_SB(0, 0), b2, voffB); PG8_STAGE(PG8_SB(0, 1), b2 + hstepB, voffB); PG8_STAGE(PG8_SA(0, 0), a2, voffA);
            PG8_WAIT_V(8); PG8_WAIT_L(0); PG8_BAR; PG8_MMA(1, 0, At, B0); PG8_MMA(1, 1, At, B1); PG8_BAR; PG8_SCHED;
            PG8_LDB(B0, 1, 0); PG8_LDB(B1, 1, 1); PG8_SCHED; PG8_LDA(At, 1, 0); PG8_STAGE(PG8_SA(0, 1), a2 + hstepA, voffA);
            PG8_WAIT_V(8); PG8_WAIT_L(0); PG8_BAR; PG8_MMA(0, 0, At, B0); PG8_MMA(0, 1, At, B1); PG8_BAR; PG8_SCHED;
            PG8_LDA(At, 1, 1); PG8_STAGE(PG8_SB(1, 0), b3, voffB); PG8_STAGE(PG8_SB(1, 1), b3 + hstepB, voffB); PG8_STAGE(PG8_SA(1, 0), a3, voffA);
            PG8_WAIT_V(8); PG8_WAIT_L(0); PG8_BAR; PG8_MMA(1, 0, At, B0); PG8_MMA(1, 1, At, B1); PG8_BAR; PG8_SCHED;
        }
        if (wr == 0) PG8_BAR;
        E(acc, cur, wr, wc, fr, fq);
        if (!has_next) break;
#pragma unroll
        for (int a = 0; a < 2; ++a)
#pragma unroll
            for (int b = 0; b < 2; ++b)
#pragma unroll
                for (int m = 0; m < 4; ++m)
#pragma unroll
                    for (int n = 0; n < 2; ++n) acc[a][b][m][n] = (f32x4){0.f, 0.f, 0.f, 0.f};
        cur = nxt; cA = nA; cB = nB; ++ui;
        if (wr == 1) PG8_BAR;
    }
    PG8_WAIT_V(0);
    PG8_BAR;
#undef PG8_SA
#undef PG8_SB
#undef PG8_STAGE
#undef PG8_LDA
#undef PG8_LDB
#undef PG8_MMA
#undef PG8_WAIT_V
#undef PG8_WAIT_L
#undef PG8_BAR
#undef PG8_SCHED
}
}

constexpr int NWAVES = 8, NTHREADS = 512;
constexpr int LDS_BYTES = 147456;
struct Ctx { int tid, lane, wave, gw, ngw, bx, G, l; unsigned char* ws; unsigned char* lds; };
__device__ __forceinline__ Ctx make_ctx(const unsigned char* ws_, unsigned char* lds, int l) {
    Ctx c; int tid = threadIdx.x; asm volatile("" : "+v"(tid));
    int bx = blockIdx.x, G = gridDim.x; asm volatile("" : "+s"(bx), "+s"(G), "+s"(l));
    unsigned long long w = (unsigned long long)ws_; asm volatile("" : "+s"(w));
    c.tid = tid; c.lane = tid & 63; c.wave = __builtin_amdgcn_readfirstlane(tid >> 6); c.bx = bx; c.G = G; c.l = l;
    c.gw = bx * NWAVES + c.wave; c.ngw = G * NWAVES; c.ws = (unsigned char*)(__attribute__((address_space(1))) unsigned char*)w; c.lds = lds; return c;
}

__device__ __forceinline__ int tr_matrix(const Ctx& C, const float* __restrict__ W, int ldn, int nsrc0, int width, int K, bf16_t* __restrict__ WT, int drow0, int mode, int rot) {
    const int nkb = K / 64, nnb = (width + 31) / 32, nitems = nkb * nnb;
    const int kc = C.lane & 7, ng = C.lane >> 3;
    int first = C.gw - (rot % C.ngw); if (first < 0) first += C.ngw;
    for (int it = first; it < nitems; it += C.ngw) {
        const int nb = it % nnb, kb = it / nnb, k0 = 64 * kb + 8 * kc, n = nb * 32 + 4 * ng;
        if (n < width) {
            const float* src = W + (size_t)k0 * ldn + nsrc0 + n;
            f32x4 v[8];
#pragma unroll
            for (int i = 0; i < 8; ++i) v[i] = __builtin_nontemporal_load((const f32x4*)(src + (size_t)i * ldn));
#pragma unroll
            for (int j = 0; j < 4; ++j) {
                const int nn = n + j, dr = (mode & 3) == 0 ? drow0 + nn : (256 * (nn >> 7) + (nn & 127) + ((mode & 3) == 2 ? 128 : 0));
                u32x4 o; o.x = pk2(v[0][j], v[1][j]); o.y = pk2(v[2][j], v[3][j]); o.z = pk2(v[4][j], v[5][j]); o.w = pk2(v[6][j], v[7][j]);
                bf16_t* dst = (mode & 4) ? WT + ((size_t)((dr >> 8) * nkb + kb) * 256 + (dr & 255)) * 64 + 8 * kc : WT + (size_t)dr * K + k0;
                *(u32x4*)dst = o; }
        }
    }
    return rot + nitems;
}
__device__ __forceinline__ void rms_rows(const Ctx& C, const float* __restrict__ x, const float* __restrict__ w, bf16_t* __restrict__ o) {
    f32x4 wv[8];
#pragma unroll
    for (int j = 0; j < 8; ++j) wv[j] = ((const f32x4*)w)[C.lane + 64 * j];
#pragma unroll 2
    for (int row = C.gw; row < T; row += C.ngw) {
        const f32x4* xr = (const f32x4*)(x + (size_t)row * DM) + C.lane; f32x4 v[8]; float s = 0.f;
#pragma unroll
        for (int j = 0; j < 8; ++j) { v[j] = xr[64 * j]; s += (v[j].x * v[j].x + v[j].y * v[j].y) + (v[j].z * v[j].z + v[j].w * v[j].w); }
        const float r = rsqrtf(wave_sum(s) * (1.f / DM) + 1e-6f);
#pragma unroll
        for (int j = 0; j < 8; ++j) { u32x2 q; q.x = pk2(v[j].x * r * wv[j].x, v[j].y * r * wv[j].y); q.y = pk2(v[j].z * r * wv[j].z, v[j].w * r * wv[j].w);
            const int col = 4 * (C.lane + 64 * j);
            *(u32x2*)(o + ((size_t)((row >> 8) * (DM / 64) + (col >> 6)) * 256 + (row & 255)) * 64 + (col & 63)) = q; }
    }
}

#define MFMA32(a, b, c) __builtin_amdgcn_mfma_f32_32x32x16_bf16((a), (b), (c), 0, 0, 0)
template <int DQK, int DV, int MODE, int VR>
__device__ __forceinline__ void attn_unit(const int tid, unsigned char* lds, const bf16_t* __restrict__ Qp, int ldq, const bf16_t* __restrict__ Kp, int ldk, const bf16_t* __restrict__ Vtp,
                                          const float* __restrict__ a2, float cscale, bf16_t* Op, int ldo, int qb, const float* __restrict__ Sprev, int vr0) {
    constexpr int KSTR = DQK * 2 + 16, VSTR = 64 * 2 + 16, KBYTES = 64 * KSTR, VBYTES = DV * VSTR, STG = KBYTES + VBYTES + 256;
    constexpr int NKS = DQK / 16, NBLK = DV / 32, KCH = DQK / 64, VCH = (DV * 8 + 511) / 512, KCPR = DQK / 8;
    static_assert(2 * STG <= 131072, "lds");
    const int lane = tid & 63, r32 = lane & 31, hi = lane >> 5, wid = __builtin_amdgcn_readfirstlane(tid >> 6);
    const int t0 = qb * 256 + wid * 32, t = t0 + r32;
    bf16x8 qf[NKS];
#pragma unroll
    for (int ks = 0; ks < NKS; ++ks) qf[ks] = *(const bf16x8*)(Qp + (size_t)t * ldq + 16 * ks + 8 * hi);
    f32x16 o[NBLK];
#pragma unroll
    for (int b = 0; b < NBLK; ++b)
#pragma unroll
        for (int r = 0; r < 16; ++r) o[b][r] = 0.f;
    float mrun = -INFINITY, lrun = 0.f;
    const float a2t = (MODE == 1) ? a2[t] : 0.f;
    const int ntiles = 4 * qb + 4, jfirst = (MODE == 1) ? 4 * qb : 0;
    const int pirow = 16 * (r32 >> 4) + 8 * ((r32 >> 2) & 1) + 4 * ((r32 >> 3) & 1) + (r32 & 3);
    u32x4 kreg[KCH], vreg[VCH]; f32x4 areg;
#define AT_IDX() int tl_ = tid; asm volatile("" : "+v"(tl_))
#define AT_KROW(i) ((tl_ + 512 * (i)) / KCPR)
#define AT_KCC(i)  ((tl_ + 512 * (i)) % KCPR)
#define AT_VCC(i)  ((tl_ + 512 * (i)) / DV)
#define AT_VDL(i)  ((((tl_ + 512 * (i)) % DV) % (DV / 2)) * 2 + ((tl_ + 512 * (i)) % DV) / (DV / 2))
#define AT_VOK(i)  ((tl_ + 512 * (i)) < DV * 8)
#define AT_LOAD(j) do { const int kv0_ = 64 * (j); AT_IDX(); \
    _Pragma("unroll") for (int i = 0; i < KCH; ++i) kreg[i] = *(const u32x4*)(Kp + (size_t)(kv0_ + AT_KROW(i)) * ldk + AT_KCC(i) * 8); \
    _Pragma("unroll") for (int i = 0; i < VCH; ++i) if (AT_VOK(i)) { const int d_ = vr0 + AT_VDL(i); vreg[i] = *(const u32x4*)(Vtp + (size_t)kv0_ * VR + (AT_VCC(i) * VR + (d_ >> 1) + (d_ & 1) * (VR / 2)) * 8); } \
    if (MODE == 1 && tid < 16) areg = *(const f32x4*)(a2 + kv0_ + tid * 4); } while (0)
#define AT_STORE(buf) do { unsigned char* b_ = lds + (buf) * STG; AT_IDX(); \
    _Pragma("unroll") for (int i = 0; i < KCH; ++i) *(u32x4*)(b_ + AT_KROW(i) * KSTR + AT_KCC(i) * 16) = kreg[i]; \
    _Pragma("unroll") for (int i = 0; i < VCH; ++i) if (AT_VOK(i)) *(u32x4*)(b_ + KBYTES + AT_VDL(i) * VSTR + AT_VCC(i) * 16) = vreg[i]; \
    if (MODE == 1 && tid < 16) *(f32x4*)(b_ + KBYTES + VBYTES + tid * 16) = areg; } while (0)
    if constexpr (MODE == 0) {
        static_assert(KBYTES % 1024 == 0 && VBYTES % 1024 == 0 && KBYTES / 1024 + VBYTES / 1024 <= 48 && 3 * STG + 5 * 1024 <= 147456, "LDS-DMA piece map");
        constexpr int NKP = KBYTES / 1024, NVP = VBYTES / 1024;
        LAS unsigned char* ldsl = (LAS unsigned char*)lds;
        unsigned goff[6];
#pragma unroll
        for (int i = 0; i < 6; ++i) { const int pc = wid + 8 * i, X = pc * 1024 + lane * 16;
            if (pc < NKP) { const int row = X / KSTR; int cb = X % KSTR; if (cb >= DQK * 2) cb = 0; goff[i] = (unsigned)(row * ldk * 2 + cb); }
            else if (pc < NKP + NVP) { const int Y = X - KBYTES, dl = Y / VSTR; int ch = (Y % VSTR) >> 4; if (ch >= 8) ch = 0; const int d = vr0 + dl;
                goff[i] = (unsigned)((ch * VR + (d >> 1) + (d & 1) * (VR / 2)) * 16); }
            else goff[i] = 0u; }
#define AT_DMA(jj) do { const int bb_ = (jj) % 3; \
        _Pragma("unroll") for (int i = 0; i < 6; ++i) { const int pc = wid + 8 * i; \
            const char* src_ = pc < NKP ? (const char*)Kp + (size_t)(jj) * 64 * ldk * 2 + goff[i] : (pc < NKP + NVP ? (const char*)Vtp + (size_t)(jj) * 64 * VR * 2 + goff[i] : (const char*)Kp); \
            const int dst_ = pc < NKP + NVP ? bb_ * STG + pc * 1024 : 3 * STG + (pc - NKP - NVP) * 1024; \
            __builtin_amdgcn_global_load_lds((const unsigned*)src_, (LAS unsigned*)(ldsl + dst_), 16, 0, 0); } } while (0)
        AT_DMA(0); AT_DMA(1);
        asm volatile("s_waitcnt vmcnt(6)" ::: "memory"); __builtin_amdgcn_s_barrier(); asm volatile("" ::: "memory");
        for (int j = 0; j < ntiles; ++j) {
            if (j + 2 < ntiles) AT_DMA(j + 2);
            const int kv0 = 64 * j;
            if (kv0 <= t0 + 31) {
                const unsigned char* Kl = lds + (j % 3) * STG; const unsigned char* Vl = Kl + KBYTES;
                const bool diag = (kv0 + 63 > t0);
                f32x16 p[2];
#pragma unroll
                for (int kb = 0; kb < 2; ++kb)
#pragma unroll
                    for (int r = 0; r < 16; ++r) p[kb][r] = 0.f;
                {
                    constexpr int NS = 2 * NKS;
                    const unsigned char* kb0 = Kl + pirow * KSTR + 16 * hi;
#define AT_KF(i) (*(const bf16x8*)(kb0 + ((i) & 1) * 32 * KSTR + ((i) >> 1) * 32))
                    bf16x8 af[3]; af[0] = AT_KF(0); af[1] = AT_KF(1);
#pragma unroll
                    for (int i = 0; i < NS; ++i) { if (i + 2 < NS) af[(i + 2) % 3] = AT_KF(i + 2); p[i & 1] = MFMA32(af[i % 3], qf[i >> 1], p[i & 1]); }
#undef AT_KF
                    __builtin_amdgcn_sched_group_barrier(0x100, 2, 0);
#pragma unroll
                    for (int i = 0; i < NS - 2; ++i) { __builtin_amdgcn_sched_group_barrier(0x100, 1, 0); __builtin_amdgcn_sched_group_barrier(0x8, 1, 0); }
                    __builtin_amdgcn_sched_group_barrier(0x8, 2, 0);
                }
                if (diag) {
#pragma unroll
                    for (int kb = 0; kb < 2; ++kb)
#pragma unroll
                        for (int r = 0; r < 16; ++r) { const int kv = kv0 + 32 * kb + 16 * (r >> 3) + 8 * hi + (r & 7); if (kv > t) p[kb][r] = -INFINITY; }
                }
                float mx = fmaxf(p[0][0], p[1][0]);
#pragma unroll
                for (int r = 1; r < 16; ++r) mx = fmaxf(mx, fmaxf(p[0][r], p[1][r]));
                mx = fmaxf(mx, __shfl_xor(mx, 32));
                const float mnew = fmaxf(mrun, mx * cscale), alpha = ex2(mrun - mnew); float ls = 0.f;
#pragma unroll
                for (int kb = 0; kb < 2; ++kb)
#pragma unroll
                    for (int r = 0; r < 16; ++r) { const float e = ex2(p[kb][r] * cscale - mnew); p[kb][r] = e; ls += e; }
                lrun = lrun * alpha + ls;
                if (__any(mnew > mrun)) {
#pragma unroll
                    for (int b = 0; b < NBLK; ++b)
#pragma unroll
                        for (int r = 0; r < 16; ++r) o[b][r] *= alpha;
                }
                mrun = mnew;
                bf16x8 pb[2][2];
#pragma unroll
                for (int kb = 0; kb < 2; ++kb)
#pragma unroll
                    for (int sl = 0; sl < 2; ++sl) { u32x4 w; w.x = pk2(p[kb][8 * sl + 0], p[kb][8 * sl + 1]); w.y = pk2(p[kb][8 * sl + 2], p[kb][8 * sl + 3]); w.z = pk2(p[kb][8 * sl + 4], p[kb][8 * sl + 5]); w.w = pk2(p[kb][8 * sl + 6], p[kb][8 * sl + 7]);
                        pb[kb][sl] = __builtin_bit_cast(bf16x8, w); }
                {
                    constexpr int NP = 4 * NBLK;
                    const unsigned char* vb0 = Vl + r32 * VSTR + 16 * hi;
#define AT_VF(i) (*(const bf16x8*)(vb0 + ((i) % NBLK) * 32 * VSTR + ((i) / NBLK) * 32))
                    bf16x8 vf[3]; vf[0] = AT_VF(0); vf[1] = AT_VF(1);
#pragma unroll
                    for (int i = 0; i < NP; ++i) { if (i + 2 < NP) vf[(i + 2) % 3] = AT_VF(i + 2); o[i % NBLK] = MFMA32(vf[i % 3], pb[(i / NBLK) >> 1][(i / NBLK) & 1], o[i % NBLK]); }
#undef AT_VF
                    __builtin_amdgcn_sched_group_barrier(0x100, 2, 1);
#pragma unroll
                    for (int i = 0; i < NP - 2; ++i) { __builtin_amdgcn_sched_group_barrier(0x100, 1, 1); __builtin_amdgcn_sched_group_barrier(0x8, 1, 1); }
                    __builtin_amdgcn_sched_group_barrier(0x8, 2, 1);
                }
            }
            if (j + 2 < ntiles) asm volatile("s_waitcnt vmcnt(6) lgkmcnt(0)" ::: "memory"); else asm volatile("s_waitcnt vmcnt(0) lgkmcnt(0)" ::: "memory");
            __builtin_amdgcn_s_barrier(); asm volatile("" ::: "memory");
        }
#undef AT_DMA
    } else {
    AT_LOAD(jfirst);
    if (MODE == 1 && qb > 0) {
        constexpr int SSTR = DQK * 2 + 16, SP_OFF = STG, NLD = DV * DQK / 4 / 512;
        static_assert(SP_OFF + DV * SSTR <= 147456, "Sprev staging");
#pragma unroll 4
        for (int i = 0; i < NLD; ++i) { const int idx = tid + 512 * i, e = idx / (DQK / 4), c4 = idx % (DQK / 4);
            const f32x4 v = *(const f32x4*)(Sprev + (size_t)e * DQK + 4 * c4);
            u32x2 w; w.x = pk2(v[0], v[1]); w.y = pk2(v[2], v[3]);
            *(u32x2*)(lds + SP_OFF + e * SSTR + c4 * 8) = w; }
        __syncthreads();
#pragma unroll
        for (int b = 0; b < NBLK; ++b)
#pragma unroll
            for (int ks = 0; ks < NKS; ++ks) { const bf16x8 a = *(const bf16x8*)(lds + SP_OFF + (32 * b + r32) * SSTR + (16 * ks + 8 * hi) * 2); o[b] = MFMA32(a, qf[ks], o[b]); }
        const float dq = ex2(a2t - a2[qb * 256 - 1]);
#pragma unroll
        for (int b = 0; b < NBLK; ++b)
#pragma unroll
            for (int r = 0; r < 16; ++r) o[b][r] *= dq;
    }
    AT_STORE(jfirst & 1);
    __syncthreads();
    for (int j = jfirst; j < ntiles; ++j) {
        if (j + 1 < ntiles) AT_LOAD(j + 1);
        const int kv0 = 64 * j;
        if (kv0 <= t0 + 31) {
            const unsigned char* Kl = lds + (j & 1) * STG; const unsigned char* Vl = Kl + KBYTES; const float* Al = (const float*)(Vl + VBYTES);
            const bool diag = (kv0 + 63 > t0);
            if (MODE == 0) {
                f32x16 p[2];
#pragma unroll
                for (int kb = 0; kb < 2; ++kb)
#pragma unroll
                    for (int r = 0; r < 16; ++r) p[kb][r] = 0.f;
                {
                    constexpr int NS = 2 * NKS;
                    const unsigned char* kb0 = Kl + pirow * KSTR + 16 * hi;
#define AT_KF(i) (*(const bf16x8*)(kb0 + ((i) & 1) * 32 * KSTR + ((i) >> 1) * 32))
                    bf16x8 af[3]; af[0] = AT_KF(0); af[1] = AT_KF(1);
#pragma unroll
                    for (int i = 0; i < NS; ++i) { if (i + 2 < NS) af[(i + 2) % 3] = AT_KF(i + 2); p[i & 1] = MFMA32(af[i % 3], qf[i >> 1], p[i & 1]); }
#undef AT_KF
                    __builtin_amdgcn_sched_group_barrier(0x100, 2, 0);
#pragma unroll
                    for (int i = 0; i < NS - 2; ++i) { __builtin_amdgcn_sched_group_barrier(0x100, 1, 0); __builtin_amdgcn_sched_group_barrier(0x8, 1, 0); }
                    __builtin_amdgcn_sched_group_barrier(0x8, 2, 0);
                }
                if (diag) {
#pragma unroll
                    for (int kb = 0; kb < 2; ++kb)
#pragma unroll
                        for (int r = 0; r < 16; ++r) { const int kv = kv0 + 32 * kb + 16 * (r >> 3) + 8 * hi + (r & 7); if (kv > t) p[kb][r] = -INFINITY; }
                }
                float mx = fmaxf(p[0][0], p[1][0]);
#pragma unroll
                for (int r = 1; r < 16; ++r) mx = fmaxf(mx, fmaxf(p[0][r], p[1][r]));
                mx = fmaxf(mx, __shfl_xor(mx, 32));
                const float mnew = fmaxf(mrun, mx * cscale), alpha = ex2(mrun - mnew); float ls = 0.f;
#pragma unroll
                for (int kb = 0; kb < 2; ++kb)
#pragma unroll
                    for (int r = 0; r < 16; ++r) { const float e = ex2(p[kb][r] * cscale - mnew); p[kb][r] = e; ls += e; }
                lrun = lrun * alpha + ls;
                if (__any(mnew > mrun)) {
#pragma unroll
                    for (int b = 0; b < NBLK; ++b)
#pragma unroll
                        for (int r = 0; r < 16; ++r) o[b][r] *= alpha;
                }
                mrun = mnew;
                bf16x8 pb[2][2];
#pragma unroll
                for (int kb = 0; kb < 2; ++kb)
#pragma unroll
                    for (int sl = 0; sl < 2; ++sl) { u32x4 w; w.x = pk2(p[kb][8 * sl + 0], p[kb][8 * sl + 1]); w.y = pk2(p[kb][8 * sl + 2], p[kb][8 * sl + 3]); w.z = pk2(p[kb][8 * sl + 4], p[kb][8 * sl + 5]); w.w = pk2(p[kb][8 * sl + 6], p[kb][8 * sl + 7]);
                        pb[kb][sl] = __builtin_bit_cast(bf16x8, w); }
                {
                    constexpr int NP = 4 * NBLK;
                    const unsigned char* vb0 = Vl + r32 * VSTR + 16 * hi;
#define AT_VF(i) (*(const bf16x8*)(vb0 + ((i) % NBLK) * 32 * VSTR + ((i) / NBLK) * 32))
                    bf16x8 vf[3]; vf[0] = AT_VF(0); vf[1] = AT_VF(1);
#pragma unroll
                    for (int i = 0; i < NP; ++i) { if (i + 2 < NP) vf[(i + 2) % 3] = AT_VF(i + 2); o[i % NBLK] = MFMA32(vf[i % 3], pb[(i / NBLK) >> 1][(i / NBLK) & 1], o[i % NBLK]); }
#undef AT_VF
                    __builtin_amdgcn_sched_group_barrier(0x100, 2, 1);
#pragma unroll
                    for (int i = 0; i < NP - 2; ++i) { __builtin_amdgcn_sched_group_barrier(0x100, 1, 1); __builtin_amdgcn_sched_group_barrier(0x8, 1, 1); }
                    __builtin_amdgcn_sched_group_barrier(0x8, 2, 1);
                }
            } else {
#pragma unroll
                for (int kb = 0; kb < 2; ++kb) {
                    if (kv0 + 32 * kb > t0 + 31) continue;
                    f32x16 p;
#pragma unroll
                    for (int r = 0; r < 16; ++r) p[r] = 0.f;
#pragma unroll
                    for (int ks = 0; ks < NKS; ++ks) { const bf16x8 a = *(const bf16x8*)(Kl + (32 * kb + pirow) * KSTR + (16 * ks + 8 * hi) * 2); p = MFMA32(a, qf[ks], p); }
                    bf16x8 pb[2];
#pragma unroll
                    for (int sl = 0; sl < 2; ++sl) {
                        const f32x4 s0 = *(const f32x4*)(Al + 32 * kb + 16 * sl + 8 * hi), s1 = *(const f32x4*)(Al + 32 * kb + 16 * sl + 8 * hi + 4);
                        float e[8];
#pragma unroll
                        for (int jj = 0; jj < 8; ++jj) { const float as = jj < 4 ? s0[jj] : s1[jj - 4]; const int kv = kv0 + 32 * kb + 16 * sl + 8 * hi + jj;
                            const float w = ex2(a2t - as); e[jj] = (diag && kv > t) ? 0.f : p[8 * sl + jj] * w; }
                        u32x4 w; w.x = pk2(e[0], e[1]); w.y = pk2(e[2], e[3]); w.z = pk2(e[4], e[5]); w.w = pk2(e[6], e[7]);
                        pb[sl] = __builtin_bit_cast(bf16x8, w);
                    }
#pragma unroll
                    for (int b = 0; b < NBLK; ++b)
#pragma unroll
                        for (int sl = 0; sl < 2; ++sl) { const bf16x8 a = *(const bf16x8*)(Vl + (32 * b + r32) * VSTR + (32 * kb + 16 * sl + 8 * hi) * 2); o[b] = MFMA32(a, pb[sl], o[b]); }
                }
            }
        }
        if (j + 1 < ntiles) AT_STORE((j + 1) & 1);
        __syncthreads();
    }
    }
#undef AT_LOAD
#undef AT_STORE
    float inv = 1.f;
    if (MODE == 0) { lrun += __shfl_xor(lrun, 32); inv = 1.f / lrun; }
    {
        constexpr int OSTR = DV * 2 + 16, CPR = DV / 8;
        unsigned char* stg = lds + wid * (32 * OSTR);
#pragma unroll
        for (int b = 0; b < NBLK; ++b)
#pragma unroll
            for (int g = 0; g < 4; ++g) { u32x2 w; w.x = pk2(o[b][4 * g] * inv, o[b][4 * g + 1] * inv); w.y = pk2(o[b][4 * g + 2] * inv, o[b][4 * g + 3] * inv);
                *(u32x2*)(stg + r32 * OSTR + (32 * b + 8 * g + 4 * hi) * 2) = w; }
        asm volatile("s_waitcnt lgkmcnt(0)" ::: "memory");
#pragma unroll
        for (int i = 0; i < DV / 16; ++i) { const int id = lane + 64 * i, row = id / CPR, ch = id % CPR;
            const u32x4 v = *(const u32x4*)(stg + row * OSTR + ch * 16);
            *(u32x4*)(Op + (size_t)(t0 + row) * ldo + ch * 8) = v; }
    }
}

#define XB_TMO      128
#define XB_XCNT(j)  (256  + 64 * (j))
#define XB_XSUB(j)  (1280 + 64 * (j))
#define XB_XGEN(j)  (2304 + 64 * (j))
#define XB_TOP      3328
#define XB_TOPGEN   3392
#define XCD_BAR_WORDS 3456
#define XB_SPIN_CAP (1u << 18)
__device__ __forceinline__ unsigned xb_ld(unsigned* p)              { return __hip_atomic_load(p, __ATOMIC_RELAXED, __HIP_MEMORY_SCOPE_AGENT); }
__device__ __forceinline__ unsigned xb_add(unsigned* p, unsigned v) { return __hip_atomic_fetch_add(p, v, __ATOMIC_RELAXED, __HIP_MEMORY_SCOPE_AGENT); }
__device__ __forceinline__ unsigned xb_xcc_id() { return (unsigned)__builtin_amdgcn_s_getreg((3 << 11) | 20) & 0xFu; }
#define XB_SPIN(cond, bar) do { unsigned _sp = 0; while (cond) { __builtin_amdgcn_s_sleep(1); \
    if ((++_sp & 255u) == 0u) { if (xb_ld(&(bar)[XB_TMO])) break; if (_sp > XB_SPIN_CAP) { atomicAdd(&(bar)[XB_TMO], 1u); break; } } } } while (0)
struct XcdBarrier { unsigned* bar; unsigned x; volatile LAS unsigned* st; };
__device__ __forceinline__ XcdBarrier xcd_barrier_post(unsigned* bar, volatile LAS unsigned* st) {
    XcdBarrier b; b.bar = bar; b.x = xb_xcc_id(); b.st = st;
    if (threadIdx.x == 0) (void)xb_add(&bar[XB_XCNT(b.x)], 1u);
    return b;
}
__device__ __forceinline__ void xcd_barrier_complete(unsigned* bar, unsigned x, unsigned& nloc, unsigned& nx) {
    const unsigned G = gridDim.x * gridDim.y * gridDim.z;
    unsigned sum, cnt, mine, sp = 0u;
    for (;;) {
        sum = 0u; cnt = 0u; mine = 0u;
#pragma unroll
        for (unsigned j = 0; j < 16; ++j) { const unsigned c = xb_ld(&bar[XB_XCNT(j)]); sum += c; cnt += (c > 0u) ? 1u : 0u; mine = (j == x) ? c : mine; }
        if (sum == G) break;
        __builtin_amdgcn_s_sleep(1);
        if ((++sp & 255u) == 0u) { if (xb_ld(&bar[XB_TMO])) break; if (sp > XB_SPIN_CAP) { atomicAdd(&bar[XB_TMO], 1u); break; } }
    }
    nloc = mine > 0u ? mine : 1u; nx = cnt > 0u ? cnt : 1u;
}
__device__ __forceinline__ void xcd_barrier(const XcdBarrier& b) {
    asm volatile("s_waitcnt vmcnt(0)" ::: "memory");
    __syncthreads();
    if (threadIdx.x == 0) {
        unsigned* bar = b.bar;
        __builtin_amdgcn_s_waitcnt(0);
        unsigned nloc = b.st[0], nx = b.st[1];
        if (nloc == 0u) { xcd_barrier_complete(bar, b.x, nloc, nx); b.st[0] = nloc; b.st[1] = nx; }
        const unsigned old = xb_add(&bar[XB_XSUB(b.x)], 1u);
        const unsigned gen = old / nloc;
        if (old + 1u == (gen + 1u) * nloc) {
            __builtin_amdgcn_fence(__ATOMIC_RELEASE, "agent");
            asm volatile("s_waitcnt vmcnt(0)" ::: "memory");
            const unsigned og = xb_add(&bar[XB_TOP], 1u);
            const unsigned tg = og / nx;
            if (og + 1u == (tg + 1u) * nx) xb_add(&bar[XB_TOPGEN], 1u);
            else XB_SPIN(xb_ld(&bar[XB_TOPGEN]) == tg, bar);
            __builtin_amdgcn_fence(__ATOMIC_ACQUIRE, "agent");
            xb_add(&bar[XB_XGEN(b.x)], 1u);
            asm volatile("s_waitcnt vmcnt(0)" ::: "memory");
        } else {
            XB_SPIN(xb_ld(&bar[XB_XGEN(b.x)]) == gen, bar);
            __builtin_amdgcn_fence(__ATOMIC_ACQUIRE, "agent");
            asm volatile("s_waitcnt vmcnt(0)" ::: "memory");
        }
    }
    __syncthreads();
}

#define WSP(T_, off) ((T_*)(C.ws + (off)))
#define PH_FN __device__ __forceinline__ void

PH_FN ph_ffn_prep(const Params& prm, unsigned char* lds, int l_, int ffn) {
    const Ctx C = make_ctx(prm.ws, lds, l_); const int l = C.l;
    const int nb = (ffn == 0) ? 2 : 26;
    const float* xb = (ffn == 0 && l == 0) ? as_global(prm.in[0]) : as_global(prm.out);
    bf16_t* WGU = WSP(bf16_t, WS_BIG + FFW_GU); bf16_t* WDN = WSP(bf16_t, WS_BIG + FFW_DN);
    int rot = 0;
    rot = tr_matrix(C, as_global(prm.in[nb + 1]) + (size_t)l * DM * DFF, DFF, 0, DFF, DM, WGU, 0, 1 | 4, rot);
    rot = tr_matrix(C, as_global(prm.in[nb + 2]) + (size_t)l * DM * DFF, DFF, 0, DFF, DM, WGU, 0, 2 | 4, rot);
    rot = tr_matrix(C, as_global(prm.in[nb + 3]) + (size_t)l * DFF * DM, DM, 0, DM, DFF, WDN, 0, 4, rot);
    rms_rows(C, xb, as_global(prm.in[nb]) + (size_t)l * DM, WSP(bf16_t, WS_H));
}
PH_FN ph_ffn_gu(const Params& prm, unsigned char* lds, int l_) {
    const Ctx C = make_ctx(prm.ws, lds, l_);
    pg8::Gemm g{WSP(bf16_t, WS_H), WSP(bf16_t, WS_BIG + FFW_GU), T, 2 * DFF, DM, DM, 1, 1}; pg8::StaticOrder S; S.init(T, 2 * DFF, C.G, C.bx);
    pg8::EpiSwiGLU E{WSP(bf16_t, WS_BIG + FF_HID), DFF};
    pg8::gemm_phase(C.tid, (LAS unsigned char*)lds, g, S, E);
}
PH_FN ph_ffn_dn(const Params& prm, unsigned char* lds, int l_, int ffn) {
    const Ctx C = make_ctx(prm.ws, lds, l_);
    const float* xb = (ffn == 0 && C.l == 0) ? as_global(prm.in[0]) : as_global(prm.out);
    pg8::Gemm g{WSP(bf16_t, WS_BIG + FF_HID), WSP(bf16_t, WS_BIG + FFW_DN), T, DM, DFF, DFF, 1, 1}; pg8::StaticOrder S; S.init(T, DM, C.G, C.bx);
    pg8::EpiResid E{xb, as_global(prm.out), 0.5f};
    pg8::gemm_phase(C.tid, (LAS unsigned char*)lds, g, S, E);
}
PH_FN ph_m0(const Params& prm, unsigned char* lds, int l_) {
    const Ctx C = make_ctx(prm.ws, lds, l_); const int l = C.l;
    bf16_t* WIN = WSP(bf16_t, WS_WA);
    const float* w_in = as_global(prm.in[7]) + (size_t)l * DM * DIN;
    int rot = 0;
    rot = tr_matrix(C, w_in, DIN, 0, 2560, DM, WIN, Z0, 4, rot);
    rot = tr_matrix(C, w_in, DIN, 2560, 16, DM, WIN, DT0, 4, rot);
    rot = tr_matrix(C, w_in, DIN, 2576, 768, DM, WIN, QL0, 4, rot);
    rot = tr_matrix(C, w_in, DIN, 3344, 576, DM, WIN, KVL0, 4, rot);
    rot = tr_matrix(C, w_in, DIN, 3920, 4096, DM, WIN, RQ0, 4, rot);
    rot = tr_matrix(C, w_in, DIN, 8016, 6144, DM, WIN, GT0, 4, rot);
    for (int i = C.gw * 64 + C.lane; i < 176 * DM / 8; i += C.ngw * 64) { const int kb = i / (176 * 8), rem = i % (176 * 8);
        ((u32x4*)(WIN + ((size_t)(15 * (DM / 64) + kb) * 256 + 80) * 64))[rem] = (u32x4){0u, 0u, 0u, 0u}; }
    rot = tr_matrix(C, as_global(prm.in[16]) + (size_t)l * 768 * 1536, 1536, 0, 1536, 768, WSP(bf16_t, WS_WS + WQB_OFF), 0, 4, rot);
    rot = tr_matrix(C, as_global(prm.in[18]) + (size_t)l * 512 * 2048, 2048, 0, 2048, 512, WSP(bf16_t, WS_WS + WKVB_OFF), 0, 4, rot);
    rot = tr_matrix(C, as_global(prm.in[22]) + (size_t)l * 1024 * 2048, 2048, 0, 2048, 1024, WSP(bf16_t, WS_WS + WBR_OFF), 0, 4, rot);
    rot = tr_matrix(C, as_global(prm.in[23]) + (size_t)l * 1024 * 2048, 2048, 0, 2048, 1024, WSP(bf16_t, WS_WS + WBR_OFF), 2048, 4, rot);
    rot = tr_matrix(C, as_global(prm.in[24]) + (size_t)l * 1024 * 2048, 2048, 0, 2048, 1024, WSP(bf16_t, WS_WS + WBR_OFF), 4096, 4, rot);
    rot = tr_matrix(C, as_global(prm.in[25]) + (size_t)l * 2048 * 2048, 2048, 0, 2048, 2048, WSP(bf16_t, WS_WS + WOUT_OFF), 0, 4, rot);
    rms_rows(C, as_global(prm.out), as_global(prm.in[6]) + (size_t)l * DM, WSP(bf16_t, WS_H));
}
PH_FN ph_m1(const Params& prm, unsigned char* lds, int l_) {
    const Ctx C = make_ctx(prm.ws, lds, l_);
    pg8::Gemm g{WSP(bf16_t, WS_H), WSP(bf16_t, WS_WA), T, NPROJ, DM, DM, 1, 1}; pg8::StaticOrder S; S.init(T, NPROJ, C.G, C.bx);
    pg8::EpiBf16 E{WSP(bf16_t, WS_BIG), LDP, as_global(prm.in[8]) + (size_t)C.l * 3 * DM, GT0, WSP(bf16_t, WS_BIG + GATE_OFF)};
    pg8::gemm_phase(C.tid, (LAS unsigned char*)lds, g, S, E);
}
PH_FN ph_m2a(const Params& prm, unsigned char* lds, int l_) {
    const Ctx C = make_ctx(prm.ws, lds, l_); const int l = C.l;
    const bf16_t* __restrict__ PROJ = WSP(bf16_t, WS_BIG); bf16_t* __restrict__ XS = WSP(bf16_t, WS_H); bf16_t* __restrict__ BC = WSP(bf16_t, WS_H) + (size_t)T * 1024;
    bf16_t* __restrict__ XT = WSP(bf16_t, WS_WA); bf16_t* __restrict__ VTR = WSP(bf16_t, WS_WA) + (size_t)T * 1024; bf16_t* __restrict__ BTS = WSP(bf16_t, WS_H) + (size_t)T * 1536;
    const float* conv_w = as_global(prm.in[9]) + (size_t)l * 4 * 1536; const float* conv_b = as_global(prm.in[10]) + (size_t)l * 1536; const float* dt_bias = as_global(prm.in[11]) + (size_t)l * 16;
    const float* a_log = as_global(prm.in[12]) + (size_t)l * 16; float* A2S = WSP(float, WS_A2S); float* A2BT = WSP(float, WS_A2BT);
    float* dts = (float*)lds;
    for (int ub = C.bx; ub < T / 64; ub += C.G) {
        const int tb = ub * 64, b = tb / SEQ, sl0 = tb % SEQ;
        __syncthreads();
        for (int i = C.tid; i < 1024; i += NTHREADS) { const int tt = i >> 4, h = i & 15;
            const float v = bf2f(PROJ[(size_t)(tb + tt) * LDP + DT0 + h]) + dt_bias[h];
            dts[i] = v > 20.f ? v : log1pf(__expf(v)); }
        __syncthreads();
#pragma unroll
        for (int hh = 0; hh < 2; ++hh) {
            const int h = 2 * C.wave + hh; const float a = -__expf(a_log[h]) * LOG2E;
            float incl = dts[C.lane * 16 + h] * a;
#pragma unroll
            for (int o = 1; o < 64; o <<= 1) { const float n = __shfl_up(incl, o); if (C.lane >= o) incl += n; }
            A2S[(size_t)(b * 16 + h) * SEQ + sl0 + C.lane] = incl;
            if (C.lane == 63) A2BT[(b * 16 + h) * 64 + (sl0 >> 6)] = incl;
        }
        for (int cp = C.tid; cp < 768; cp += NTHREADS) {
            const int c = 2 * cp;
            const f32x2 w0 = *(const f32x2*)(conv_w + c), w1 = *(const f32x2*)(conv_w + 1536 + c), w2 = *(const f32x2*)(conv_w + 3072 + c), w3 = *(const f32x2*)(conv_w + 4608 + c), cb = *(const f32x2*)(conv_b + c);
            f32x2 xm3 = {0.f, 0.f}, xm2 = {0.f, 0.f}, xm1 = {0.f, 0.f};
            const bf16_t* __restrict__ src = PROJ + (size_t)tb * LDP + XBC0 + c;
            if (sl0 > 0) { unsigned u;
                u = *(const unsigned*)(src - 3 * (size_t)LDP); xm3 = (f32x2){bf2f(u & 0xffffu), bf2f(u >> 16)};
                u = *(const unsigned*)(src - 2 * (size_t)LDP); xm2 = (f32x2){bf2f(u & 0xffffu), bf2f(u >> 16)};
                u = *(const unsigned*)(src - 1 * (size_t)LDP); xm1 = (f32x2){bf2f(u & 0xffffu), bf2f(u >> 16)}; }
            const int h = (c >> 6) & 15;
            const bool isx = c < 1024, isb = (c >= 1024 && c < 1280);
            const int rr = isx ? 64 : 128, r0 = isx ? ((c & 63) >> 1) : (((c - 1024) & 127) >> 1);
            bf16_t* __restrict__ d0 = (isx ? XT + (size_t)(b * 16 + h) * 64 * SEQ : BTS + (size_t)(b * 2 + ((c - 1024) >> 7)) * 128 * SEQ) + ((size_t)(sl0 >> 3) * rr + r0) * 8;
            for (int t8 = 0; t8 < 8; ++t8) {
                float e0[8], e1[8];
#pragma unroll
                for (int ti = 0; ti < 8; ++ti) { const int tt = t8 * 8 + ti;
                    const unsigned u = *(const unsigned*)(src + (size_t)tt * LDP); const f32x2 xc = {bf2f(u & 0xffffu), bf2f(u >> 16)};
                    f32x2 y = cb + w0 * xm3 + w1 * xm2 + w2 * xm1 + w3 * xc; xm3 = xm2; xm2 = xm1; xm1 = xc;
                    y.x = siluf_(y.x); y.y = siluf_(y.y);
                    const float d = isx ? dts[tt * 16 + h] : 1.f; e0[ti] = y.x * d; e1[ti] = y.y * d;
                    if (isx) *(unsigned*)(XS + (size_t)(tb + tt) * 1024 + c) = pk2(y.x, y.y);
                    else *(unsigned*)(BC + (size_t)(tb + tt) * 512 + (c - 1024)) = pk2(y.x, y.y); }
                if (isx || isb) {
                    *(u32x4*)(d0 + (size_t)t8 * rr * 8) = (u32x4){pk2(e0[0], e0[1]), pk2(e0[2], e0[3]), pk2(e0[4], e0[5]), pk2(e0[6], e0[7])};
                    *(u32x4*)(d0 + (size_t)t8 * rr * 8 + (rr / 2) * 8) = (u32x4){pk2(e1[0], e1[1]), pk2(e1[2], e1[3]), pk2(e1[4], e1[5]), pk2(e1[6], e1[7])}; }
            }
        }
        {
            const int c = 2 * C.tid, h = c >> 8, e = c & 255;
            const bf16_t* __restrict__ src = PROJ + (size_t)tb * LDP + RV0 + c;
            bf16_t* __restrict__ d0 = VTR + (size_t)(b * 4 + h) * 256 * SEQ + ((size_t)(sl0 >> 3) * 256 + (e >> 1)) * 8;
            for (int t8 = 0; t8 < 8; ++t8) { unsigned u[8];
#pragma unroll
                for (int ti = 0; ti < 8; ++ti) u[ti] = *(const unsigned*)(src + (size_t)(t8 * 8 + ti) * LDP);
                u32x4 lo, hi2;
                lo.x = (u[0] & 0xffffu) | (u[1] << 16); lo.y = (u[2] & 0xffffu) | (u[3] << 16); lo.z = (u[4] & 0xffffu) | (u[5] << 16); lo.w = (u[6] & 0xffffu) | (u[7] << 16);
                hi2.x = (u[0] >> 16) | (u[1] & 0xffff0000u); hi2.y = (u[2] >> 16) | (u[3] & 0xffff0000u); hi2.z = (u[4] >> 16) | (u[5] & 0xffff0000u); hi2.w = (u[6] >> 16) | (u[7] & 0xffff0000u);
                *(u32x4*)(d0 + (size_t)t8 * 256 * 8) = lo; *(u32x4*)(d0 + (size_t)t8 * 256 * 8 + 128 * 8) = hi2; }
        }
    }
}
PH_FN ph_m2b(const Params& prm, unsigned char* lds, int l_) {
    const Ctx C = make_ctx(prm.ws, lds, l_); const int l = C.l;
    bf16_t* PROJ = WSP(bf16_t, WS_BIG); const int* positions = (const int*)as_global(prm.in[1]);
    bf16_t* QLN = WSP(bf16_t, WS_R2); bf16_t* CKVN = WSP(bf16_t, WS_R2) + (size_t)T * 768;
    const float* qan = as_global(prm.in[15]) + (size_t)l * 768; const float* kvan = as_global(prm.in[17]) + (size_t)l * 512;
    f32x4 qw[3], kw0, kw1; float invf[2];
#pragma unroll
    for (int j = 0; j < 3; ++j) qw[j] = *(const f32x4*)(qan + 4 * C.lane + 256 * j);
    kw0 = *(const f32x4*)(kvan + 8 * C.lane); kw1 = *(const f32x4*)(kvan + 8 * C.lane + 4);
#pragma unroll
    for (int e = 0; e < 2; ++e) invf[e] = 1.0f / exp2f((float)(2 * C.lane + e) * (13.287712379549449f / 128.f));
    for (int row = C.gw; row < T; row += C.ngw) {
        bf16_t* pr = PROJ + (size_t)row * LDP;
        u32x2 qu[3]; u32x4 ku; unsigned r1[2][4], r2[2][4];
#pragma unroll
        for (int j = 0; j < 3; ++j) qu[j] = *(const u32x2*)(pr + QL0 + 4 * C.lane + 256 * j);
        ku = *(const u32x4*)(pr + KVL0 + 8 * C.lane);
#pragma unroll
        for (int qk = 0; qk < 2; ++qk)
#pragma unroll
            for (int h = 0; h < 4; ++h) { const bf16_t* p1 = pr + (qk ? RK0 : RQ0) + h * 256 + 2 * C.lane; r1[qk][h] = *(const unsigned*)p1; r2[qk][h] = *(const unsigned*)(p1 + 128); }
        const float pos = (float)positions[row];
        {
            float v[12]; float s = 0.f;
#pragma unroll
            for (int j = 0; j < 3; ++j) { v[4 * j] = bf2f(qu[j].x & 0xffffu); v[4 * j + 1] = bf2f(qu[j].x >> 16); v[4 * j + 2] = bf2f(qu[j].y & 0xffffu); v[4 * j + 3] = bf2f(qu[j].y >> 16); }
            float v2[8];
            v2[0] = bf2f(ku.x & 0xffffu); v2[1] = bf2f(ku.x >> 16); v2[2] = bf2f(ku.y & 0xffffu); v2[3] = bf2f(ku.y >> 16); v2[4] = bf2f(ku.z & 0xffffu); v2[5] = bf2f(ku.z >> 16); v2[6] = bf2f(ku.w & 0xffffu); v2[7] = bf2f(ku.w >> 16);
            float s2 = 0.f;
#pragma unroll
            for (int j = 0; j < 12; ++j) s += v[j] * v[j];
#pragma unroll
            for (int j = 0; j < 8; ++j) s2 += v2[j] * v2[j];
#pragma unroll
            for (int o = 1; o < 64; o <<= 1) { s += __shfl_xor(s, o); s2 += __shfl_xor(s2, o); }
            const float r = rsqrtf(s * (1.f / 768.f) + 1e-6f), rk = rsqrtf(s2 * (1.f / 512.f) + 1e-6f);
#pragma unroll
            for (int j = 0; j < 3; ++j) { const f32x4 w = qw[j]; u32x2 o; o.x = pk2(v[4 * j] * r * w[0], v[4 * j + 1] * r * w[1]); o.y = pk2(v[4 * j + 2] * r * w[2], v[4 * j + 3] * r * w[3]);
                { const int c = 4 * C.lane + 256 * j; *(u32x2*)(QLN + ((size_t)((row >> 8) * 12 + (c >> 6)) * 256 + (row & 255)) * 64 + (c & 63)) = o; } }
            u32x4 o; o.x = pk2(v2[0] * rk * kw0[0], v2[1] * rk * kw0[1]); o.y = pk2(v2[2] * rk * kw0[2], v2[3] * rk * kw0[3]); o.z = pk2(v2[4] * rk * kw1[0], v2[5] * rk * kw1[1]); o.w = pk2(v2[6] * rk * kw1[2], v2[7] * rk * kw1[3]);
            { const int c = 8 * C.lane; *(u32x4*)(CKVN + ((size_t)((row >> 8) * 8 + (c >> 6)) * 256 + (row & 255)) * 64 + (c & 63)) = o; }
        }
        {
            float cs[2], sn[2];
#pragma unroll
            for (int e = 0; e < 2; ++e) sincos_rev(pos * invf[e], cs[e], sn[e]);
#pragma unroll
            for (int qk = 0; qk < 2; ++qk)
#pragma unroll
                for (int h = 0; h < 4; ++h) { bf16_t* p1 = pr + (qk ? RK0 : RQ0) + h * 256 + 2 * C.lane; const float sc = qk ? 0.0625f : 1.f;
                    const unsigned u1 = r1[qk][h], u2 = r2[qk][h];
                    const float a0 = bf2f(u1 & 0xffffu), a1 = bf2f(u1 >> 16), b0 = bf2f(u2 & 0xffffu), b1 = bf2f(u2 >> 16);
                    *(unsigned*)p1 = pk2((a0 * cs[0] - b0 * sn[0]) * sc, (a1 * cs[1] - b1 * sn[1]) * sc);
                    *(unsigned*)(p1 + 128) = pk2((a0 * sn[0] + b0 * cs[0]) * sc, (a1 * sn[1] + b1 * cs[1]) * sc); }
        }
    }
}
PH_FN ph_m2c(const Params& prm, unsigned char* lds, int l_) {
    const Ctx C = make_ctx(prm.ws, lds, l_); const int l = C.l;
    const bf16_t* PROJ = WSP(bf16_t, WS_BIG); float* A2S = WSP(float, WS_A2S); float* A2R = WSP(float, WS_A2R);
    const float* dt_bias = as_global(prm.in[11]) + (size_t)l * 16; const float* a_log = as_global(prm.in[12]) + (size_t)l * 16;
    if (C.gw < 64) {
    } else if (C.gw < 68) {
        const int h = C.gw - 64; const float lg2 = log2f(1.f - exp2f(-(5.f + 7.f * (float)h / 3.f)));
        for (int i = C.lane; i < SEQ; i += 64) A2R[h * SEQ + i] = (float)i * lg2;
    }
}
PH_FN ph_m3a(const Params& prm, unsigned char* lds, int l_) {
    const Ctx C = make_ctx(prm.ws, lds, l_);
    pg8::Gemm g{WSP(bf16_t, WS_R2), WSP(bf16_t, WS_WS + WQB_OFF), T, 1536, 768, 768, 1, 1}; pg8::StaticOrder S; S.init(T, 1536, C.G, C.bx);
    pg8::EpiBf16 E{WSP(bf16_t, WS_R1), 1536, nullptr, 0, nullptr};
    pg8::gemm_phase(C.tid, (LAS unsigned char*)lds, g, S, E);
}
PH_FN ph_m3b(const Params& prm, unsigned char* lds, int l_) {
    const Ctx C = make_ctx(prm.ws, lds, l_);
    pg8::Gemm g{WSP(bf16_t, WS_R2) + (size_t)T * 768, WSP(bf16_t, WS_WS + WKVB_OFF), T, 2048, 512, 512, 1, 1}; pg8::StaticOrder S; S.init(T, 2048, C.G, C.bx);
    pg8::EpiBf16 E{WSP(bf16_t, WS_R1) + (size_t)T * 1536, 2048, nullptr, 0, nullptr};
    pg8::gemm_phase(C.tid, (LAS unsigned char*)lds, g, S, E);
}
PH_FN ph_m4a(const Params& prm, unsigned char* lds, int l_) {
    const Ctx C = make_ctx(prm.ws, lds, l_);
    const bf16_t* KVb = WSP(bf16_t, WS_R1) + (size_t)T * 1536; bf16_t* VTM = WSP(bf16_t, WS_R2) + (size_t)2 * T * 8 * 192;
    for (int ub = C.bx; ub < T / 64; ub += C.G) {
        const int tb = ub * 64, b = tb / SEQ, sl0 = tb % SEQ;
        const int c = 2 * C.tid, h = c >> 7, d = c & 127;
        const bf16_t* __restrict__ src = KVb + (size_t)tb * 2048 + h * 256 + 128 + d;
        bf16_t* __restrict__ d0 = VTM + (size_t)(b * 8 + h) * 128 * SEQ + ((size_t)(sl0 >> 3) * 128 + (d >> 1)) * 8;
        for (int t8 = 0; t8 < 8; ++t8) { unsigned u[8];
#pragma unroll
            for (int ti = 0; ti < 8; ++ti) u[ti] = *(const unsigned*)(src + (size_t)(t8 * 8 + ti) * 2048);
            u32x4 lo, hi2;
            lo.x = (u[0] & 0xffffu) | (u[1] << 16); lo.y = (u[2] & 0xffffu) | (u[3] << 16); lo.z = (u[4] & 0xffffu) | (u[5] << 16); lo.w = (u[6] & 0xffffu) | (u[7] << 16);
            hi2.x = (u[0] >> 16) | (u[1] & 0xffff0000u); hi2.y = (u[2] >> 16) | (u[3] & 0xffff0000u); hi2.z = (u[4] >> 16) | (u[5] & 0xffff0000u); hi2.w = (u[6] >> 16) | (u[7] & 0xffff0000u);
            *(u32x4*)(d0 + (size_t)t8 * 128 * 8) = lo; *(u32x4*)(d0 + (size_t)t8 * 128 * 8 + 64 * 8) = hi2; }
    }
}
PH_FN ph_m4b(const Params& prm, unsigned char* lds, int l_) {
    const Ctx C = make_ctx(prm.ws, lds, l_); const int l = C.l;
    const bf16_t* __restrict__ PROJ = WSP(bf16_t, WS_BIG); const bf16_t* __restrict__ Qb = WSP(bf16_t, WS_R1); const bf16_t* __restrict__ KVb = Qb + (size_t)T * 1536;
    bf16_t* __restrict__ QH = WSP(bf16_t, WS_R2); bf16_t* __restrict__ KH = QH + (size_t)T * 8 * 192;
    const int* positions = (const int*)as_global(prm.in[1]);
    const float* qn = as_global(prm.in[19]) + (size_t)l * 192; const float* kn = as_global(prm.in[20]) + (size_t)l * 192;
    const int h = C.lane >> 3, j = C.lane & 7;
    float qw[24], kw[24], invf[4];
#pragma unroll
    for (int e = 0; e < 8; ++e) { qw[e] = qn[8 * j + e]; kw[e] = kn[8 * j + e]; qw[8 + e] = qn[64 + 8 * j + e]; kw[8 + e] = kn[64 + 8 * j + e]; }
#pragma unroll
    for (int e = 0; e < 4; ++e) { qw[16 + e] = qn[128 + 4 * j + e]; qw[20 + e] = qn[160 + 4 * j + e]; kw[16 + e] = kn[128 + 4 * j + e]; kw[20 + e] = kn[160 + 4 * j + e];
        invf[e] = 1.0f / exp2f((float)(4 * j + e) * (13.287712379549449f / 32.f)); }
    for (int row = C.gw; row < T; row += C.ngw) {
        const int b = row / SEQ, sq = row % SEQ;
        const bf16_t* q = Qb + (size_t)row * 1536 + h * 192; const bf16_t* k = KVb + (size_t)row * 2048 + h * 256; const bf16_t* pe = PROJ + (size_t)row * LDP + KPE0;
        const u32x4 qa = *(const u32x4*)(q + 8 * j), qb2 = *(const u32x4*)(q + 64 + 8 * j); const u32x2 qr1 = *(const u32x2*)(q + 128 + 4 * j), qr2 = *(const u32x2*)(q + 160 + 4 * j);
        const u32x4 ka = *(const u32x4*)(k + 8 * j), kb2 = *(const u32x4*)(k + 64 + 8 * j); const u32x2 kr1 = *(const u32x2*)(pe + 4 * j), kr2 = *(const u32x2*)(pe + 32 + 4 * j);
        const float pos = (float)positions[row];
        float cs[4], sn[4];
#pragma unroll
        for (int e = 0; e < 4; ++e) sincos_rev(pos * invf[e], cs[e], sn[e]);
        float qv[24], kv[24];
#pragma unroll
        for (int e = 0; e < 4; ++e) { qv[2 * e] = bf2f(qa[e] & 0xffffu); qv[2 * e + 1] = bf2f(qa[e] >> 16); qv[8 + 2 * e] = bf2f(qb2[e] & 0xffffu); qv[8 + 2 * e + 1] = bf2f(qb2[e] >> 16);
            kv[2 * e] = bf2f(ka[e] & 0xffffu); kv[2 * e + 1] = bf2f(ka[e] >> 16); kv[8 + 2 * e] = bf2f(kb2[e] & 0xffffu); kv[8 + 2 * e + 1] = bf2f(kb2[e] >> 16); }
#pragma unroll
        for (int e = 0; e < 2; ++e) { qv[16 + 2 * e] = bf2f(qr1[e] & 0xffffu); qv[16 + 2 * e + 1] = bf2f(qr1[e] >> 16); qv[20 + 2 * e] = bf2f(qr2[e] & 0xffffu); qv[20 + 2 * e + 1] = bf2f(qr2[e] >> 16);
            kv[16 + 2 * e] = bf2f(kr1[e] & 0xffffu); kv[16 + 2 * e + 1] = bf2f(kr1[e] >> 16); kv[20 + 2 * e] = bf2f(kr2[e] & 0xffffu); kv[20 + 2 * e + 1] = bf2f(kr2[e] >> 16); }
        float sq_ = 0.f, sk_ = 0.f;
#pragma unroll
        for (int e = 0; e < 24; ++e) { sq_ += qv[e] * qv[e]; sk_ += kv[e] * kv[e]; }
#pragma unroll
        for (int o = 1; o < 8; o <<= 1) { sq_ += __shfl_xor(sq_, o); sk_ += __shfl_xor(sk_, o); }
        const float rq = rsqrtf(sq_ * (1.f / 192.f) + 1e-6f), rk = rsqrtf(sk_ * (1.f / 192.f) + 1e-6f);
#pragma unroll
        for (int e = 0; e < 24; ++e) { qv[e] *= rq * qw[e]; kv[e] *= rk * kw[e]; }
        float q1[4], q2[4], k1[4], k2[4];
#pragma unroll
        for (int e = 0; e < 4; ++e) { q1[e] = qv[16 + e] * cs[e] - qv[20 + e] * sn[e]; q2[e] = qv[16 + e] * sn[e] + qv[20 + e] * cs[e];
            k1[e] = kv[16 + e] * cs[e] - kv[20 + e] * sn[e]; k2[e] = kv[16 + e] * sn[e] + kv[20 + e] * cs[e]; }
        bf16_t* dq = QH + ((size_t)(b * 8 + h) * SEQ + sq) * 192; bf16_t* dk = KH + ((size_t)(b * 8 + h) * SEQ + sq) * 192;
        *(u32x4*)(dq + 8 * j) = (u32x4){pk2(qv[0], qv[1]), pk2(qv[2], qv[3]), pk2(qv[4], qv[5]), pk2(qv[6], qv[7])};
        *(u32x4*)(dq + 64 + 8 * j) = (u32x4){pk2(qv[8], qv[9]), pk2(qv[10], qv[11]), pk2(qv[12], qv[13]), pk2(qv[14], qv[15])};
        *(u32x2*)(dq + 128 + 4 * j) = (u32x2){pk2(q1[0], q1[1]), pk2(q1[2], q1[3])}; *(u32x2*)(dq + 160 + 4 * j) = (u32x2){pk2(q2[0], q2[1]), pk2(q2[2], q2[3])};
        *(u32x4*)(dk + 8 * j) = (u32x4){pk2(kv[0], kv[1]), pk2(kv[2], kv[3]), pk2(kv[4], kv[5]), pk2(kv[6], kv[7])};
        *(u32x4*)(dk + 64 + 8 * j) = (u32x4){pk2(kv[8], kv[9]), pk2(kv[10], kv[11]), pk2(kv[12], kv[13]), pk2(kv[14], kv[15])};
        *(u32x2*)(dk + 128 + 4 * j) = (u32x2){pk2(k1[0], k1[1]), pk2(k1[2], k1[3])}; *(u32x2*)(dk + 160 + 4 * j) = (u32x2){pk2(k2[0], k2[1]), pk2(k2[2], k2[3])};
    }
}

PH_FN ph_m4c(const Params& prm, unsigned char* lds, int l_) {
    const Ctx C = make_ctx(prm.ws, lds, l_);
    const bf16_t* PROJ = WSP(bf16_t, WS_BIG); bf16_t* KTR = WSP(bf16_t, WS_Y) + (size_t)2 * T * 1024;
    for (int ub = C.bx; ub < T / 64; ub += C.G) {
        const int tb = ub * 64, b = tb / SEQ, sl0 = tb % SEQ;
        const int c = 2 * C.tid, h = c >> 8, e = c & 255;
        const bf16_t* __restrict__ src = PROJ + (size_t)tb * LDP + RK0 + c;
        bf16_t* __restrict__ d0 = KTR + (size_t)(b * 4 + h) * 256 * SEQ + ((size_t)(sl0 >> 3) * 256 + (e >> 1)) * 8;
        for (int t8 = 0; t8 < 8; ++t8) { unsigned u[8];
#pragma unroll
            for (int ti = 0; ti < 8; ++ti) u[ti] = *(const unsigned*)(src + (size_t)(t8 * 8 + ti) * LDP);
            u32x4 lo, hi2;
            lo.x = (u[0] & 0xffffu) | (u[1] << 16); lo.y = (u[2] & 0xffffu) | (u[3] << 16); lo.z = (u[4] & 0xffffu) | (u[5] << 16); lo.w = (u[6] & 0xffffu) | (u[7] << 16);
            hi2.x = (u[0] >> 16) | (u[1] & 0xffff0000u); hi2.y = (u[2] >> 16) | (u[3] & 0xffff0000u); hi2.z = (u[4] >> 16) | (u[5] & 0xffff0000u); hi2.w = (u[6] >> 16) | (u[7] & 0xffff0000u);
            *(u32x4*)(d0 + (size_t)t8 * 256 * 8) = lo; *(u32x4*)(d0 + (size_t)t8 * 256 * 8 + 128 * 8) = hi2; }
    }
}

PH_FN ph_m4d(const Params& prm, unsigned char* lds, int l_) {
    const Ctx C = make_ctx(prm.ws, lds, l_);
    if (C.gw < 64) {
        float* a2 = WSP(float, WS_A2S) + (size_t)C.gw * SEQ + 64 * C.lane;
        const float tot = WSP(float, WS_A2BT)[C.gw * 64 + C.lane];
        float incl = tot;
#pragma unroll
        for (int o = 1; o < 64; o <<= 1) { const float n = __shfl_up(incl, o); if (C.lane >= o) incl += n; }
        const float pre = incl - tot;
#pragma unroll
        for (int i = 0; i < 16; ++i) { f32x4 v = ((f32x4*)a2)[i]; v = v + pre; ((f32x4*)a2)[i] = v; }
    }
}
template <int DK, int DV, int NH>
__device__ __forceinline__ void state_unit(const int tid, unsigned char* lds, const bf16_t* __restrict__ Vt  , size_t vhs, const bf16_t* __restrict__ Kt  , int tc0  ,
                                           const float* __restrict__ a2c, size_t ahs, float* __restrict__ ST, size_t shs) {
    constexpr int NEB = DV / 32, NDB = DK / 32, NDBW = NEB * NDB / 8, KS = 528, NCH = DK * 32 / 512;
    const int lane = tid & 63, r32 = lane & 31, hi = lane >> 5, wid = __builtin_amdgcn_readfirstlane(tid >> 6);
    const int eb = wid % NEB, db0 = (wid / NEB) * NDBW;
    __syncthreads();
#pragma unroll
    for (int i0 = 0; i0 < NCH; i0 += 8) { u32x4 v[8];
#pragma unroll
        for (int i = 0; i < 8; ++i) { const int id = tid + 512 * (i0 + i), sg = id % DK, cc = id / DK; v[i] = *(const u32x4*)(Kt + ((size_t)(tc0 + cc) * DK + sg) * 8); }
#pragma unroll
        for (int i = 0; i < 8; ++i) { const int id = tid + 512 * (i0 + i), sg = id % DK, cc = id / DK, d = sg < DK / 2 ? 2 * sg : 2 * (sg - DK / 2) + 1; *(u32x4*)(lds + d * KS + cc * 16) = v[i]; } }
    __syncthreads();
    const unsigned char* kl = lds + (32 * db0 + r32) * KS + 16 * hi;
    const int e = 32 * eb + r32, esrc = ((e >> 1) + (e & 1) * (DV / 2)) * 8;
    for (int hh = 0; hh < NH; ++hh) {
        f32x16 acc[NDBW];
#pragma unroll
        for (int i = 0; i < NDBW; ++i)
#pragma unroll
            for (int r = 0; r < 16; ++r) acc[i][r] = 0.f;
        const float* a2h = a2c + hh * ahs; const float aend = a2h[255];
        const bf16_t* vp = Vt + hh * vhs + (size_t)(tc0 + hi) * DV * 8 + esrc;
#pragma unroll 4
        for (int ks = 0; ks < 16; ++ks) {
            const u32x4 av = *(const u32x4*)(vp + (size_t)(2 * ks) * DV * 8);
            const f32x4 w0 = *(const f32x4*)(a2h + 16 * ks + 8 * hi), w1 = *(const f32x4*)(a2h + 16 * ks + 8 * hi + 4);
            u32x4 as;
            as.x = pk2(bf2f(av.x & 0xffffu) * ex2(aend - w0[0]), bf2f(av.x >> 16) * ex2(aend - w0[1]));
            as.y = pk2(bf2f(av.y & 0xffffu) * ex2(aend - w0[2]), bf2f(av.y >> 16) * ex2(aend - w0[3]));
            as.z = pk2(bf2f(av.z & 0xffffu) * ex2(aend - w1[0]), bf2f(av.z >> 16) * ex2(aend - w1[1]));
            as.w = pk2(bf2f(av.w & 0xffffu) * ex2(aend - w1[2]), bf2f(av.w >> 16) * ex2(aend - w1[3]));
            const bf16x8 a = __builtin_bit_cast(bf16x8, as);
#pragma unroll
            for (int i = 0; i < NDBW; ++i) { const bf16x8 bq = *(const bf16x8*)(kl + (32 * i) * KS + 32 * ks); acc[i] = MFMA32(a, bq, acc[i]); }
        }
        float* st = ST + hh * shs;
#pragma unroll
        for (int i = 0; i < NDBW; ++i)
#pragma unroll
            for (int r = 0; r < 16; ++r) st[(size_t)(32 * eb + (r & 3) + 8 * (r >> 2) + 4 * hi) * DK + 32 * (db0 + i) + r32] = acc[i][r];
    }
}
PH_FN ph_state(const Params& prm, unsigned char* lds, int l_) {
    const Ctx C = make_ctx(prm.ws, lds, l_);
    const bf16_t* XT = WSP(bf16_t, WS_WA); const bf16_t* VTR = XT + (size_t)T * 1024; const bf16_t* BTS = WSP(bf16_t, WS_H) + (size_t)T * 1536;
    const bf16_t* KTR = WSP(bf16_t, WS_Y) + (size_t)2 * T * 1024;
    float* STR = WSP(float, WS_R1); float* STS = STR + (size_t)T * 1024;
    for (int u = C.bx; u < 512; u += C.G) {
        int tid = C.tid; asm volatile("" : "+v"(tid));
        if (u < 256) { const int b = u >> 6, c = (u >> 2) & 15, h = u & 3;
            state_unit<256, 256, 1>(tid, lds, VTR + (size_t)(b * 4 + h) * 256 * SEQ, 0, KTR + (size_t)(b * 4 + h) * 256 * SEQ, c * 32, WSP(float, WS_A2R) + h * SEQ + c * 256, 0,
                                    STR + (size_t)((b * 16 + c) * 4 + h) * 65536, 0);
        } else { const int v = u - 256, b = v >> 6, c = (v >> 2) & 15, g = (v >> 1) & 1, h0 = g * 8 + (v & 1) * 4;
            state_unit<128, 64, 4>(tid, lds, XT + (size_t)(b * 16 + h0) * 64 * SEQ, (size_t)64 * SEQ, BTS + (size_t)(b * 2 + g) * 128 * SEQ, c * 32,
                                   WSP(float, WS_A2S) + (size_t)(b * 16 + h0) * SEQ + c * 256, (size_t)SEQ, STS + (size_t)((b * 16 + c) * 16 + h0) * 8192, (size_t)8192);
        }
    }
}
PH_FN ph_scan(const Params& prm, unsigned char* lds, int l_) {
    const Ctx C = make_ctx(prm.ws, lds, l_);
    float* STR = WSP(float, WS_R1); float* STS = STR + (size_t)T * 1024;
    const float* A2S = WSP(float, WS_A2S); const float* A2R = WSP(float, WS_A2R);
    const int gt = C.bx * NTHREADS + C.tid, ngt = C.G * NTHREADS;
    for (int i = gt; i < 4 * 4 * 16384; i += ngt) {
        const int b = i >> 16, h = (i >> 14) & 3, el = i & 16383;
        const float dec = ex2(A2R[h * SEQ + 256]);
        f32x4 loc[16];
#pragma unroll
        for (int c = 0; c < 16; ++c) loc[c] = *((const f32x4*)(STR + (size_t)((b * 16 + c) * 4 + h) * 65536) + el);
        f32x4 run = {0.f, 0.f, 0.f, 0.f};
#pragma unroll
        for (int c = 0; c < 16; ++c) { *((f32x4*)(STR + (size_t)((b * 16 + c) * 4 + h) * 65536) + el) = run; run = run * dec + loc[c]; }
    }
    for (int i = gt; i < 4 * 16 * 2048; i += ngt) {
        const int b = i >> 15, h = (i >> 11) & 15, el = i & 2047;
        const float* a2 = A2S + (size_t)(b * 16 + h) * SEQ;
        f32x4 loc[16]; float dec[16];
#pragma unroll
        for (int c = 0; c < 16; ++c) { loc[c] = *((const f32x4*)(STS + (size_t)((b * 16 + c) * 16 + h) * 8192) + el); dec[c] = ex2(a2[c * 256 + 255] - (c ? a2[c * 256 - 1] : 0.f)); }
        f32x4 run = {0.f, 0.f, 0.f, 0.f};
#pragma unroll
        for (int c = 0; c < 16; ++c) { *((f32x4*)(STS + (size_t)((b * 16 + c) * 16 + h) * 8192) + el) = run; run = run * dec[c] + loc[c]; }
    }
}
PH_FN ph_m5(const Params& prm, unsigned char* lds, int l_, int* s_unit) {
    const Ctx C = make_ctx(prm.ws, lds, l_);
    unsigned* qctr = WSP(unsigned, WS_CTL) + 64 * (C.l + 1);
    bf16_t* Yb = WSP(bf16_t, WS_Y);
    for (;;) {
        __syncthreads();
        if (C.tid == 0) *s_unit = (int)atomicAdd(qctr, 1u);
        __syncthreads();
        int idx = *s_unit; idx = __builtin_amdgcn_readfirstlane(idx);
        if (idx >= 2048) break;
        int tid = C.tid; asm volatile("" : "+v"(tid));
        if (idx < 512) {
            const int qb = 15 - (idx >> 5), rem = idx & 31;
            const int b = rem >> 3, h = rem & 7; const size_t bh = (size_t)(b * 8 + h);
            const bf16_t* QH = WSP(bf16_t, WS_R2); const bf16_t* KH = QH + (size_t)T * 8 * 192; const bf16_t* VTM = KH + (size_t)T * 8 * 192;
            attn_unit<192, 128, 0, 128>(tid, lds, QH + bh * SEQ * 192, 192, KH + bh * SEQ * 192, 192, VTM + bh * 128 * SEQ, nullptr, 0.07216878364870322f * LOG2E,
                                   Yb + (size_t)T * 1024 + (size_t)b * SEQ * 1024 + h * 128, 1024, qb, nullptr, 0);
        } else if (idx < 1024) {
            const int qb = (idx - 512) >> 5, r2 = idx & 31, b = r2 >> 3, h = (r2 & 7) >> 1, half = r2 & 1;
            const bf16_t* PROJ = WSP(bf16_t, WS_BIG); const bf16_t* VTR = WSP(bf16_t, WS_WA) + (size_t)T * 1024;
            attn_unit<256, 128, 1, 256>(tid, lds, PROJ + (size_t)b * SEQ * LDP + RQ0 + h * 256, LDP, PROJ + (size_t)b * SEQ * LDP + RK0 + h * 256, LDP,
                                   VTR + (size_t)(b * 4 + h) * 256 * SEQ, WSP(float, WS_A2R) + h * SEQ, 0.f,
                                   Yb + (size_t)2 * T * 1024 + (size_t)b * SEQ * 1024 + h * 256 + half * 128, 1024, qb,
                                   WSP(float, WS_R1) + ((size_t)((b * 16 + qb) * 4 + h) * 256 + half * 128) * 256, half * 128);
        } else {
            const int qb = (idx - 1024) >> 6, r3 = idx & 63, b = r3 >> 4, h = r3 & 15, gq = h >> 3;
            const bf16_t* BC = WSP(bf16_t, WS_H) + (size_t)T * 1024; const bf16_t* XT = WSP(bf16_t, WS_WA);
            attn_unit<128, 64, 1, 64>(tid, lds, BC + (size_t)b * SEQ * 512 + 256 + gq * 128, 512, BC + (size_t)b * SEQ * 512 + gq * 128, 512,
                                  XT + (size_t)(b * 16 + h) * 64 * SEQ, WSP(float, WS_A2S) + (size_t)(b * 16 + h) * SEQ, 0.f,
                                  Yb + (size_t)b * SEQ * 1024 + h * 64, 1024, qb,
                                  WSP(float, WS_R1) + (size_t)T * 1024 + (size_t)((b * 16 + qb) * 16 + h) * 64 * 128, 0);
        }
    }
}
PH_FN ph_m6(const Params& prm, unsigned char* lds, int l_) {
    const Ctx C = make_ctx(prm.ws, lds, l_); const int l = C.l;
    const bf16_t* PROJ = WSP(bf16_t, WS_BIG); const bf16_t* XS = WSP(bf16_t, WS_H); bf16_t* Yb = WSP(bf16_t, WS_Y);
    const float* dsk = as_global(prm.in[13]) + (size_t)l * 16; const float* ssn = as_global(prm.in[14]) + (size_t)l * 1024; const float* rtn = as_global(prm.in[21]) + (size_t)l * 1024;
    f32x4 sw[2][2]; f32x4 rw[4]; float ds[2];
#pragma unroll
    for (int gq = 0; gq < 2; ++gq) { const int c0 = gq * 512 + 8 * C.lane; ds[gq] = dsk[c0 >> 6]; sw[gq][0] = *(const f32x4*)(ssn + c0); sw[gq][1] = *(const f32x4*)(ssn + c0 + 4); }
#pragma unroll
    for (int h = 0; h < 4; ++h) rw[h] = *(const f32x4*)(rtn + h * 256 + 4 * C.lane);
    for (int row = C.gw; row < T; row += C.ngw) {
        const bf16_t* pr = PROJ + (size_t)row * LDP;
        bf16_t* y0 = Yb + (size_t)row * 1024; bf16_t* y2 = Yb + (size_t)2 * T * 1024 + (size_t)row * 1024;
        u32x4 yu[2], xu[2], zu[2]; u32x2 ru[4], gu[4];
#pragma unroll
        for (int gq = 0; gq < 2; ++gq) { const int c0 = gq * 512 + 8 * C.lane; yu[gq] = *(const u32x4*)(y0 + c0); xu[gq] = *(const u32x4*)(XS + (size_t)row * 1024 + c0); zu[gq] = *(const u32x4*)(pr + Z0 + c0); }
#pragma unroll
        for (int h = 0; h < 4; ++h) { const int c0 = h * 256 + 4 * C.lane; ru[h] = *(const u32x2*)(y2 + c0); gu[h] = *(const u32x2*)(pr + RG0 + c0); }
        float v[2][8], ss[6];
#pragma unroll
        for (int gq = 0; gq < 2; ++gq) { float s = 0.f;
#pragma unroll
            for (int j = 0; j < 4; ++j) { const unsigned a = yu[gq][j], xx = xu[gq][j], zz = zu[gq][j];
                v[gq][2 * j] = (bf2f(a & 0xffffu) + ds[gq] * bf2f(xx & 0xffffu)) * siluf_(bf2f(zz & 0xffffu));
                v[gq][2 * j + 1] = (bf2f(a >> 16) + ds[gq] * bf2f(xx >> 16)) * siluf_(bf2f(zz >> 16)); }
#pragma unroll
            for (int j = 0; j < 8; ++j) s += v[gq][j] * v[gq][j];
            ss[gq] = s; }
        float rv[4][4];
#pragma unroll
        for (int h = 0; h < 4; ++h) { rv[h][0] = bf2f(ru[h].x & 0xffffu); rv[h][1] = bf2f(ru[h].x >> 16); rv[h][2] = bf2f(ru[h].y & 0xffffu); rv[h][3] = bf2f(ru[h].y >> 16);
            ss[2 + h] = rv[h][0] * rv[h][0] + rv[h][1] * rv[h][1] + rv[h][2] * rv[h][2] + rv[h][3] * rv[h][3]; }
#pragma unroll
        for (int o = 1; o < 64; o <<= 1) {
#pragma unroll
            for (int q = 0; q < 6; ++q) ss[q] += __shfl_xor(ss[q], o); }
#pragma unroll
        for (int gq = 0; gq < 2; ++gq) { const float r = rsqrtf(ss[gq] * (1.f / 512.f) + 1e-6f); const f32x4 w0 = sw[gq][0], w1 = sw[gq][1];
            u32x4 o; o.x = pk2(v[gq][0] * r * w0[0], v[gq][1] * r * w0[1]); o.y = pk2(v[gq][2] * r * w0[2], v[gq][3] * r * w0[3]); o.z = pk2(v[gq][4] * r * w1[0], v[gq][5] * r * w1[1]); o.w = pk2(v[gq][6] * r * w1[2], v[gq][7] * r * w1[3]);
            *(u32x4*)(y0 + gq * 512 + 8 * C.lane) = o; }
#pragma unroll
        for (int h = 0; h < 4; ++h) { const float r = rsqrtf(ss[2 + h] * (1.f / 256.f) + 1e-6f); const f32x4 w = rw[h];
            const float g0 = bf2f(gu[h].x & 0xffffu), g1 = bf2f(gu[h].x >> 16), g2 = bf2f(gu[h].y & 0xffffu), g3 = bf2f(gu[h].y >> 16);
            u32x2 o; o.x = pk2(rv[h][0] * r * w[0] * siluf_(g0), rv[h][1] * r * w[1] * siluf_(g1)); o.y = pk2(rv[h][2] * r * w[2] * siluf_(g2), rv[h][3] * r * w[3] * siluf_(g3));
            *(u32x2*)(y2 + h * 256 + 4 * C.lane) = o; }
    }
}
PH_FN ph_m7(const Params& prm, unsigned char* lds, int l_) {
    const Ctx C = make_ctx(prm.ws, lds, l_);
    pg8::Gemm g{WSP(bf16_t, WS_Y), WSP(bf16_t, WS_WS + WBR_OFF), T, DM, 1024, 1024, 0, 1}; pg8::MergeOrder S; S.so.init(T, DM, C.G, C.bx);
    pg8::EpiMerge E{WSP(bf16_t, WS_BIG + GATE_OFF), WSP(bf16_t, WS_H)};
    pg8::gemm_phase(C.tid, (LAS unsigned char*)lds, g, S, E);
}
PH_FN ph_m8(const Params& prm, unsigned char* lds, int l_) {
    const Ctx C = make_ctx(prm.ws, lds, l_);
    pg8::Gemm g{WSP(bf16_t, WS_H), WSP(bf16_t, WS_WS + WOUT_OFF), T, DM, DM, DM, 1, 1}; pg8::StaticOrder S; S.init(T, DM, C.G, C.bx);
    pg8::EpiResid E{as_global(prm.out), as_global(prm.out), 1.0f};
    pg8::gemm_phase(C.tid, (LAS unsigned char*)lds, g, S, E);
}

#ifndef PHMASK
#define PHMASK 0xffffffu
#endif
#define GSYNC() xcd_barrier(xbar)
#define PH(k, call) do { if constexpr ((PHMASK >> (k)) & 1u) { call; } GSYNC(); } while (0)
__global__ void __launch_bounds__(NTHREADS, 2) fwd_kernel(Params prm) {
    extern __shared__ __attribute__((aligned(16))) unsigned char lds[];
    __shared__ int s_unit;
    __shared__ unsigned s_bar[2];
    cg::grid_group grid = cg::this_grid();
    if (threadIdx.x < 2) s_bar[threadIdx.x] = 0u;
    __syncthreads();
    if (blockIdx.x == 0) { unsigned* ctl0 = (unsigned*)(as_global(prm.ws) + WS_CTL); for (int i = threadIdx.x; i < 8192; i += NTHREADS) ctl0[i] = 0u; }
    XcdBarrier xbar; xbar.bar = nullptr; xbar.x = 0u; xbar.st = nullptr;
    for (int l = 0; l < DEPTH; ++l) {
        for (int ffn = 0; ffn < 2; ++ffn) {
            if (ffn == 1) {
                PH(0, ph_m0(prm, lds, l));
                PH(1, ph_m1(prm, lds, l));
                if constexpr ((PHMASK >> 2) & 1u) { ph_m2a(prm, lds, l); ph_m2b(prm, lds, l); ph_m2c(prm, lds, l); }
                GSYNC();
                if constexpr ((PHMASK >> 3) & 1u) { ph_m3a(prm, lds, l); ph_m3b(prm, lds, l); }
                GSYNC();
                if constexpr ((PHMASK >> 4) & 1u) { ph_m4a(prm, lds, l); ph_m4b(prm, lds, l); ph_m4c(prm, lds, l); ph_m4d(prm, lds, l); }
                GSYNC();
                PH(12, ph_state(prm, lds, l));
                PH(13, ph_scan(prm, lds, l));
                PH(5, ph_m5(prm, lds, l, &s_unit));
                PH(6, ph_m6(prm, lds, l));
                PH(7, ph_m7(prm, lds, l));
                PH(8, ph_m8(prm, lds, l));
            }
            if constexpr ((PHMASK >> 9) & 1u) { ph_ffn_prep(prm, lds, l, ffn); }
            if (l == 0 && ffn == 0) { grid.sync();
                xbar = xcd_barrier_post((unsigned*)(as_global(prm.ws) + WS_CTL) + 1024, (volatile LAS unsigned*)s_bar); }
            else GSYNC();
            PH(10, ph_ffn_gu(prm, lds, l));
            PH(11, ph_ffn_dn(prm, lds, l, ffn));
        }
    }
}

extern "C" void kernel_launch(void* const* d_in, const int* in_sizes, int n_in, void* d_out, int out_size, void* d_ws, size_t ws_size, hipStream_t stream) {
    static int grid = 0;
    if (grid == 0) {
        if (n_in != 30 || out_size != T * DM || ws_size < WS_END) { fprintf(stderr, "kernel_launch: unexpected shapes / workspace (n_in %d out %d ws %zu need %zu)\n", n_in, out_size, ws_size, (size_t)WS_END); grid = -1; return; }
        int dev = 0, cus = 0, per_cu = 0;
        hipGetDevice(&dev);
        hipDeviceGetAttribute(&cus, hipDeviceAttributeMultiprocessorCount, dev);
        hipFuncSetAttribute((const void*)fwd_kernel, hipFuncAttributeMaxDynamicSharedMemorySize, LDS_BYTES);
        hipOccupancyMaxActiveBlocksPerMultiprocessor(&per_cu, (const void*)fwd_kernel, NTHREADS, LDS_BYTES);
        if (per_cu < 1) per_cu = 1;
        grid = cus * per_cu;
        (void)hipGetLastError();
    }
    if (grid < 0) return;
    Params p{};
    for (int i = 0; i < 30; ++i) p.in[i] = (const float*)d_in[i];
    p.out = (float*)d_out; p.ws = (unsigned char*)d_ws;
    void* args[] = {&p};
    hipError_t e = hipLaunchCooperativeKernel((const void*)fwd_kernel, dim3(grid), dim3(NTHREADS), args, LDS_BYTES, stream);
    if (e != hipSuccess) fprintf(stderr, "cooperative launch failed: %s (grid %d)\n", hipGetErrorString(e), grid);
}
```
